# Optimizing an MI355X kernel written in HIP

```python
import jax, jax.numpy as jnp
from jax import lax
import numpy as np

D_MODEL = 1024
BATCH = 16
SEQ = 2048
DEPTH = 1

GRID_W = 64
CTX_LEN = 256
FOURIER_WIDTH = D_MODEL // 4
FOURIER_GROUPS = 4
FOURIER_GROUP_DIM = FOURIER_WIDTH // FOURIER_GROUPS
RET_WIDTH = D_MODEL - FOURIER_WIDTH
RET_HEADS = 6
RET_V_DIM = RET_WIDTH // RET_HEADS
RET_QK_DIM = RET_V_DIM // 2
RET_QK_WIDTH = RET_HEADS * RET_QK_DIM
RET_CHUNK = 128
ROPE_BASE = 10000.0
D_FF = -(-8 * D_MODEL // (3 * 256)) * 256
PROJ_WIDTH = FOURIER_WIDTH + 2 * RET_QK_WIDTH + 2 * RET_WIDTH
LN_EPS = 1e-6
DEEPNORM_ALPHA = (2.0 * DEPTH) ** 0.25
DEEPNORM_BETA = (8.0 * DEPTH) ** -0.25

kernel_name = "hymba_fnet_retnet_deepnorm_dit"

F32 = jnp.float32


def layer_norm(x, g=None, b=None):
    x32 = x.astype(F32)
    mu = jnp.mean(x32, axis=-1, keepdims=True)
    var = jnp.mean(jnp.square(x32 - mu), axis=-1, keepdims=True)
    y = (x32 - mu) * lax.rsqrt(var + LN_EPS)
    if g is not None:
        y = y * g.astype(F32) + b.astype(F32)
    return y.astype(x.dtype)


def modulate(xn, shift, scale):
    return xn * (1.0 + scale) + shift


def rope_1d(x, pos):
    nf = x.shape[-1] // 2
    freqs = ROPE_BASE ** (-jnp.arange(nf, dtype=F32) / nf)
    ang = pos[:, None] * freqs[None, :]
    cos = jnp.cos(ang)[None, :, None, :]
    sin = jnp.sin(ang)[None, :, None, :]
    x32 = x.astype(F32)
    x1, x2 = x32[..., :nf], x32[..., nf:]
    return jnp.concatenate([x1 * cos - x2 * sin, x1 * sin + x2 * cos], axis=-1).astype(x.dtype)


def axial_rope(x, row_pos, col_pos):
    half = x.shape[-1] // 2
    return jnp.concatenate([rope_1d(x[..., :half], row_pos), rope_1d(x[..., half:], col_pos)], axis=-1)


def chunk_retention(q, k, v, log_gamma, state0, strict):
    B, N, H, dk = q.shape
    dv = v.shape[-1]
    nC = N // RET_CHUNK
    idx = jnp.arange(RET_CHUNK, dtype=F32)
    diff = idx[:, None] - idx[None, :]
    mask = (diff > 0) if strict else (diff >= 0)
    safe = jnp.where(mask, diff, 0.0)
    decay_inner = jnp.where(mask[None], jnp.exp(log_gamma[:, None, None] * safe[None]), 0.0)
    xi = jnp.exp(log_gamma[:, None] * (idx[None, :] + 1.0))
    zeta = jnp.exp(log_gamma[:, None] * (RET_CHUNK - 1.0 - idx[None, :]))
    g_chunk = jnp.exp(log_gamma * RET_CHUNK)

    def to_chunks(t, d):
        return t.astype(F32).reshape(B, nC, RET_CHUNK, H, d).transpose(1, 0, 3, 2, 4)

    qc, kc, vc = to_chunks(q, dk), to_chunks(k, dk), to_chunks(v, dv)

    def step(state, inp):
        qi, ki, vi = inp
        scores = jnp.einsum('bhcd,bhld->bhcl', qi, ki) * decay_inner[None]
        inner = jnp.einsum('bhcl,bhle->bhce', scores, vi)
        cross = jnp.einsum('bhcd,bhde->bhce', qi, state) * xi[None, :, :, None]
        new_state = g_chunk[None, :, None, None] * state + jnp.einsum(
            'bhld,bhle->bhde', ki * zeta[None, :, :, None], vi)
        return new_state, inner + cross

    final, out = lax.scan(step, state0, (qc, kc, vc))
    out = out.transpose(1, 0, 3, 2, 4).reshape(B, N, H, dv)
    return out, final


def bidirectional_retention(q, k, v, lg_f, lg_b, state_f, state_b):
    rev = lambda t: jnp.flip(t, axis=1)
    y_f, fin_f = chunk_retention(q, k, v, lg_f, state_f, False)
    y_b, fin_b = chunk_retention(rev(q), rev(k), rev(v), lg_b, state_b, True)
    return y_f + rev(y_b), fin_f, fin_b


def mixer_inputs(u, w_in):
    p = u @ w_in
    f, q, k, v, g = jnp.split(p, [FOURIER_WIDTH, FOURIER_WIDTH + RET_QK_WIDTH,
                                  FOURIER_WIDTH + 2 * RET_QK_WIDTH,
                                  FOURIER_WIDTH + 2 * RET_QK_WIDTH + RET_WIDTH], axis=-1)
    B, N = u.shape[0], u.shape[1]
    q = q.reshape(B, N, RET_HEADS, RET_QK_DIM)
    k = k.reshape(B, N, RET_HEADS, RET_QK_DIM) * (RET_QK_DIM ** -0.5)
    v = v.reshape(B, N, RET_HEADS, RET_V_DIM)
    return f, q, k, v, g


def fourier_mix(f):
    B, N, _ = f.shape
    fg = f.reshape(B, N, FOURIER_GROUPS, FOURIER_GROUP_DIM).astype(F32)
    out = jnp.fft.fft2(fg, axes=(1, 3), norm="ortho").real
    return out.reshape(B, N, FOURIER_WIDTH).astype(f.dtype)


def gated_group_norm(y, g):
    B, N = y.shape[0], y.shape[1]
    y = y * lax.rsqrt(jnp.mean(jnp.square(y), axis=-1, keepdims=True) + LN_EPS)
    return (y.reshape(B, N, RET_WIDTH) * jax.nn.silu(g.astype(F32))).astype(g.dtype)


def swiglu(u, wg, wu, wd):
    return (jax.nn.silu(u @ wg) * (u @ wu)) @ wd


def setup_inputs(seed: int = 0) -> dict:
    key = jax.random.key(seed)
    ks = jax.random.split(key, 16)
    nrm = lambda k, shape, s: jax.random.normal(k, shape, F32) * s
    h = jnp.arange(RET_HEADS, dtype=F32)
    p = 2.0 ** (-5.0 - h)
    decay_logit = jnp.log((1.0 - p) / p)
    return {
        "x": nrm(ks[0], (BATCH, SEQ, D_MODEL), 1.0),
        "c": nrm(ks[1], (BATCH, D_MODEL), 1.0),
        "ctx": nrm(ks[2], (BATCH, CTX_LEN, D_MODEL), 1.0),
        "c_ctx": nrm(ks[3], (D_MODEL,), 1.0),
        "w_mod": nrm(ks[4], (DEPTH, D_MODEL, 6 * D_MODEL), 0.5 * D_MODEL ** -0.5),
        "b_mod": nrm(ks[5], (DEPTH, 6 * D_MODEL), 0.01),
        "w_in": nrm(ks[6], (DEPTH, D_MODEL, PROJ_WIDTH), D_MODEL ** -0.5),
        "w_out": nrm(ks[7], (DEPTH, D_MODEL, D_MODEL), DEEPNORM_BETA * D_MODEL ** -0.5),
        "decay_fwd": decay_logit[None, :] + nrm(ks[8], (DEPTH, RET_HEADS), 0.1),
        "decay_bwd": decay_logit[None, :] + nrm(ks[9], (DEPTH, RET_HEADS), 0.1),
        "ln1_g": 1.0 + nrm(ks[10], (DEPTH, D_MODEL), 0.02),
        "ln1_b": nrm(ks[11], (DEPTH, D_MODEL), 0.02),
        "w_ffn_gate": nrm(ks[12], (DEPTH, D_MODEL, D_FF), D_MODEL ** -0.5),
        "w_ffn_up": nrm(ks[13], (DEPTH, D_MODEL, D_FF), D_MODEL ** -0.5),
        "w_ffn_down": nrm(ks[14], (DEPTH, D_FF, D_MODEL), DEEPNORM_BETA * D_FF ** -0.5),
        "ln2_g": 1.0 + nrm(ks[15], (DEPTH, D_MODEL), 0.02),
        "ln2_b": nrm(jax.random.fold_in(ks[15], 1), (DEPTH, D_MODEL), 0.02),
    }


def reference(x, c, ctx, c_ctx, w_mod, b_mod, w_in, w_out, decay_fwd, decay_bwd,
              ln1_g, ln1_b, w_ffn_gate, w_ffn_up, w_ffn_down, ln2_g, ln2_b):
    B, N, _ = x.shape
    rows = N // GRID_W
    row_pos = jnp.repeat(jnp.arange(rows), GRID_W).astype(F32)
    col_pos = jnp.tile(jnp.arange(GRID_W), rows).astype(F32)
    state0 = jnp.zeros((B, RET_HEADS, RET_QK_DIM, RET_V_DIM), F32)

    for l in range(DEPTH):
        last = l == DEPTH - 1
        mod_x = jax.nn.silu(c) @ w_mod[l] + b_mod[l]
        mod_c = jax.nn.silu(c_ctx) @ w_mod[l] + b_mod[l]
        sh1, sc1, gt1, sh2, sc2, gt2 = jnp.split(mod_x[:, None, :], 6, axis=-1)
        csh1, csc1, cgt1, csh2, csc2, cgt2 = jnp.split(mod_c[None, None, :], 6, axis=-1)
        lg_f = jax.nn.log_sigmoid(decay_fwd[l].astype(F32))
        lg_b = jax.nn.log_sigmoid(decay_bwd[l].astype(F32))

        uc = modulate(layer_norm(ctx), csh1, csc1)
        fc, qc, kc, vc, gc = mixer_inputs(uc, w_in[l])
        yc, st_f, st_b = bidirectional_retention(qc, kc, vc, lg_f, lg_b, state0, state0)

        u = modulate(layer_norm(x), sh1, sc1)
        f, q, k, v, g = mixer_inputs(u, w_in[l])
        q = axial_rope(q, row_pos, col_pos)
        k = axial_rope(k, row_pos, col_pos)
        y, _, _ = bidirectional_retention(q, k, v, lg_f, lg_b, st_f, st_b)
        mix = jnp.concatenate([fourier_mix(f), gated_group_norm(y, g)], axis=-1) @ w_out[l]
        x = layer_norm(DEEPNORM_ALPHA * x + gt1 * mix, ln1_g[l], ln1_b[l])
        u2 = modulate(layer_norm(x), sh2, sc2)
        x = layer_norm(DEEPNORM_ALPHA * x + gt2 * swiglu(u2, w_ffn_gate[l], w_ffn_up[l], w_ffn_down[l]),
                       ln2_g[l], ln2_b[l])

        if not last:
            mix_c = jnp.concatenate([fourier_mix(fc), gated_group_norm(yc, gc)], axis=-1) @ w_out[l]
            ctx = layer_norm(DEEPNORM_ALPHA * ctx + cgt1 * mix_c, ln1_g[l], ln1_b[l])
            uc2 = modulate(layer_norm(ctx), csh2, csc2)
            ctx = layer_norm(DEEPNORM_ALPHA * ctx + cgt2 * swiglu(uc2, w_ffn_gate[l], w_ffn_up[l], w_ffn_down[l]),
                             ln2_g[l], ln2_b[l])

    return x
```

```cpp
#include <hip/hip_runtime.h>
#include <hip/hip_cooperative_groups.h>
#include <cstdio>
#include <cstdint>
namespace cg = cooperative_groups;
namespace pg8 {
#define PG8_LAS __attribute__((address_space(3)))
typedef unsigned short bf16_t;
typedef short bf16x8 __attribute__((ext_vector_type(8)));
typedef float f32x4 __attribute__((ext_vector_type(4)));
typedef unsigned u32x4 __attribute__((ext_vector_type(4)));
constexpr int BM = 256, BK = 64, HALF = 128, HTB = HALF * BK * 2  , STAGE_BYTES = 8 * HTB, NXCD = 8, WGM = 8;

__host__ __device__ __forceinline__ int lds_byte(int r, int c) { const int st = (r >> 4) * 2 + (c >> 5), rr = r & 15, cc = c & 31, ob = rr * 64 + cc * 2; return st * 1024 + (ob ^ (((ob >> 9) & 1) << 5)); }
__host__ __device__ __forceinline__ void stage_rc(int b, int& R, int& C) { const int st = b / 1024, sb = b % 1024, swz = sb ^ (((sb >> 9) & 1) << 5); R = (st >> 1) * 16 + swz / 64; C = (st & 1) * 32 + (swz % 64) / 2; }
__host__ __device__ __forceinline__ int perm32(int rho) { const int n = rho >> 4, i = rho & 15; return 8 * (i >> 2) + 4 * n + (i & 3); }

struct Unit { int pm, pn; };
struct Gemm { const bf16_t* A; const bf16_t* Bt; int M, N, K; };

struct StaticOrder {
    int nM, nN, nwg, G, c;
    __host__ __device__ void init(int M, int N, int G_, int c_) { nM = M / BM; nN = N / BM; nwg = nM * nN; G = G_; c = c_; }
    __host__ __device__ bool next(int i, Unit& u) const {
        const long L = (long)i * G + c; if (L >= nwg) return false;
        int wgid = (int)L; { const int q = nwg / NXCD, r = nwg % NXCD, xcd = wgid % NXCD, off = wgid / NXCD; wgid = (xcd < r ? xcd * (q + 1) : r * (q + 1) + (xcd - r) * q) + off; }
        const int nig = WGM * nN, gid = wgid / nig, fm = gid * WGM, gsz = (nM - fm) < WGM ? (nM - fm) : WGM;
        u.pm = fm + ((wgid % nig) % gsz); u.pn = (wgid % nig) / gsz; return true;
    }
    __device__ __forceinline__ void a_ready(const Unit&) const {}
    __device__ __forceinline__ void done(const Unit&) const {}
};
__device__ __forceinline__ unsigned cvt_pk_bf16(float lo, float hi) { unsigned r; asm volatile("v_cvt_pk_bf16_f32 %0, %1, %2" : "=v"(r) : "v"(lo), "v"(hi)); return r; }
typedef float f32x2 __attribute__((ext_vector_type(2)));
template <class Epi, class Sched, bool ALIGN_EPI = false, bool SP2 = false>
__device__ __forceinline__ void gemm_phase(PG8_LAS unsigned char* lds, const Gemm g, const Sched& S, const Epi& E) {
    const int tid = threadIdx.x, wid = __builtin_amdgcn_readfirstlane(tid >> 6), lane = tid & 63, wr = wid >> 2, wc = wid & 3, fr = lane & 15, fq = lane >> 4;
    const int K = g.K, nt = K / BK;
    unsigned voffA[2], voffB[2];
#pragma unroll
    for (int i = 0; i < 2; ++i) { int R, C; stage_rc(tid * 16 + i * 8192, R, C); const int Rb = Epi::PERM ? ((R & ~31) + perm32(R & 31)) : R;
        voffA[i] = (unsigned)(R * K + C) * 2u; voffB[i] = (unsigned)(Rb * K + C) * 2u; }
    const size_t kstep = (size_t)(BK * 2);
    const size_t hstep = (size_t)HALF * K * 2;
    const size_t tstep = 2 * hstep;
    const unsigned ldsw = (unsigned)wid * 1024u;
    const int aoff = lds_byte(wr * 64 + fr, fq * 8), boff = lds_byte(wc * 32 + fr, fq * 8);
#define PG8_SA(b, h) (((b) * 2 + (h)) * HTB)
#define PG8_SB(b, h) ((4 + (b) * 2 + (h)) * HTB)
#define PG8_STAGE(bufoff, gbase, voff) do { _Pragma("unroll") for (int _i = 0; _i < 2; ++_i) \
        __builtin_amdgcn_global_load_lds((const unsigned*)((const char*)(gbase) + (voff)[_i]), (PG8_LAS unsigned*)(lds + (bufoff) + ldsw + _i * 8192), 16, 0, 0); } while (0)
#define PG8_LDA(dst, b, h) do { _Pragma("unroll") for (int m = 0; m < 4; ++m) _Pragma("unroll") for (int k = 0; k < 2; ++k) dst[m][k] = *(const PG8_LAS bf16x8*)(lds + PG8_SA(b, h) + aoff + m * 2048 + k * 1024); } while (0)
#define PG8_LDB(dst, b, h) do { _Pragma("unroll") for (int n = 0; n < 2; ++n) _Pragma("unroll") for (int k = 0; k < 2; ++k) dst[n][k] = *(const PG8_LAS bf16x8*)(lds + PG8_SB(b, h) + boff + n * 2048 + k * 1024); } while (0)
#define PG8_MMA(ai, bj, At, Bt) do { __builtin_amdgcn_s_setprio(1); _Pragma("unroll") for (int m = 0; m < 4; ++m) _Pragma("unroll") for (int n = 0; n < 2; ++n) _Pragma("unroll") for (int k = 0; k < 2; ++k) \
        acc[ai][bj][m][n] = __builtin_amdgcn_mfma_f32_16x16x32_bf16(Bt[n][k], At[m][k], acc[ai][bj][m][n], 0, 0, 0); __builtin_amdgcn_s_setprio(0); } while (0)
#define PG8_WAIT_V(n) asm volatile("s_waitcnt vmcnt(" #n ")" ::: "memory")
#define PG8_WAIT_L(n) asm volatile("s_waitcnt lgkmcnt(" #n ")" ::: "memory")
#define PG8_BAR __builtin_amdgcn_s_barrier()
#define PG8_SCHED __builtin_amdgcn_sched_barrier(0)
    Unit cur, nxt; int ui = 0;
    if (!S.next(0, cur)) return;
    f32x4 acc[2][2][4][2];
#pragma unroll
    for (int a = 0; a < 2; ++a)
#pragma unroll
        for (int b = 0; b < 2; ++b)
#pragma unroll
            for (int m = 0; m < 4; ++m)
#pragma unroll
                for (int n = 0; n < 2; ++n) acc[a][b][m][n] = (f32x4){0.f, 0.f, 0.f, 0.f};
    bf16x8 At[4][2], B0[2][2], B1[2][2];
    const char* cA = (const char*)g.A + (size_t)cur.pm * tstep; const char* cB = (const char*)g.Bt + (size_t)cur.pn * tstep;
    S.a_ready(cur);
    if constexpr (SP2) {
        PG8_STAGE(PG8_SB(0, 0), cB, voffB); PG8_STAGE(PG8_SB(0, 1), cB + hstep, voffB); PG8_STAGE(PG8_SA(0, 0), cA, voffA); PG8_STAGE(PG8_SA(0, 1), cA + hstep, voffA);
        if (wr == 1) PG8_BAR;
        PG8_WAIT_V(2); PG8_BAR;
        PG8_STAGE(PG8_SB(1, 0), cB + kstep, voffB); PG8_STAGE(PG8_SA(1, 0), cA + kstep, voffA); PG8_STAGE(PG8_SB(1, 1), cB + hstep + kstep, voffB);
        PG8_WAIT_V(6); PG8_BAR;
    } else {
        PG8_STAGE(PG8_SB(0, 0), cB, voffB); PG8_STAGE(PG8_SA(0, 0), cA, voffA); PG8_STAGE(PG8_SB(0, 1), cB + hstep, voffB); PG8_STAGE(PG8_SA(0, 1), cA + hstep, voffA);
        if (wr == 1) PG8_BAR;
        PG8_WAIT_V(4); PG8_BAR;
        PG8_STAGE(PG8_SB(1, 0), cB + kstep, voffB); PG8_STAGE(PG8_SA(1, 0), cA + kstep, voffA); PG8_STAGE(PG8_SB(1, 1), cB + hstep + kstep, voffB);
        PG8_WAIT_V(6); PG8_BAR;
    }
    for (;;) {
        const bool has_next = S.next(ui + 1, nxt);
        const char* nA = has_next ? (const char*)g.A + (size_t)nxt.pm * tstep : cA; const char* nB = has_next ? (const char*)g.Bt + (size_t)nxt.pn * tstep : cB;
        for (int t = 0; t < nt; t += 2) {
            const bool last = (t == nt - 2);
            const char* a1 = cA + (size_t)(t + 1) * kstep;
            const char* a2 = last ? nA : cA + (size_t)(t + 2) * kstep; const char* b2 = last ? nB : cB + (size_t)(t + 2) * kstep;
            const char* a3 = a2 + kstep; const char* b3 = b2 + kstep;
            if (last && has_next) S.a_ready(nxt);
            if constexpr (SP2) {
            PG8_LDB(B0, 0, 0); PG8_LDB(B1, 0, 1); PG8_SCHED; PG8_LDA(At, 0, 0); PG8_STAGE(PG8_SA(1, 1), a1 + hstep, voffA);
            PG8_WAIT_V(8); PG8_WAIT_L(0); PG8_BAR; PG8_MMA(0, 0, At, B0); PG8_MMA(0, 1, At, B1); PG8_BAR; PG8_SCHED;
            PG8_LDA(At, 0, 1); PG8_STAGE(PG8_SB(0, 0), b2, voffB); PG8_STAGE(PG8_SB(0, 1), b2 + hstep, voffB); PG8_STAGE(PG8_SA(0, 0), a2, voffA);
            PG8_WAIT_V(8); PG8_WAIT_L(0); PG8_BAR; PG8_MMA(1, 0, At, B0); PG8_MMA(1, 1, At, B1); PG8_BAR; PG8_SCHED;
            PG8_LDB(B0, 1, 0); PG8_LDB(B1, 1, 1); PG8_SCHED; PG8_LDA(At, 1, 0); PG8_STAGE(PG8_SA(0, 1), a2 + hstep, voffA);
            PG8_WAIT_V(8); PG8_WAIT_L(0); PG8_BAR; PG8_MMA(0, 0, At, B0); PG8_MMA(0, 1, At, B1); PG8_BAR; PG8_SCHED;
            PG8_LDA(At, 1, 1); PG8_STAGE(PG8_SB(1, 0), b3, voffB); PG8_STAGE(PG8_SB(1, 1), b3 + hstep, voffB); PG8_STAGE(PG8_SA(1, 0), a3, voffA);
            PG8_WAIT_V(8); PG8_WAIT_L(0); PG8_BAR; PG8_MMA(1, 0, At, B0); PG8_MMA(1, 1, At, B1); PG8_BAR; PG8_SCHED;
            } else {
            PG8_LDB(B0, 0, 0); PG8_SCHED; PG8_LDA(At, 0, 0); PG8_STAGE(PG8_SA(1, 1), a1 + hstep, voffA);
            PG8_WAIT_L(8); PG8_BAR; PG8_WAIT_L(0); PG8_MMA(0, 0, At, B0); PG8_BAR; PG8_SCHED;
            PG8_LDB(B1, 0, 1); PG8_STAGE(PG8_SB(0, 0), b2, voffB);
            PG8_BAR; PG8_WAIT_L(0); PG8_MMA(0, 1, At, B1); PG8_BAR;
            PG8_LDA(At, 0, 1); PG8_STAGE(PG8_SA(0, 0), a2, voffA);
            PG8_BAR; PG8_WAIT_L(0); PG8_MMA(1, 0, At, B0); PG8_BAR; PG8_SCHED;
            PG8_STAGE(PG8_SB(0, 1), b2 + hstep, voffB);
            PG8_WAIT_V(6); PG8_BAR; PG8_MMA(1, 1, At, B1); PG8_BAR;
            PG8_LDB(B0, 1, 0); PG8_SCHED; PG8_LDA(At, 1, 0); PG8_STAGE(PG8_SA(0, 1), a2 + hstep, voffA);
            PG8_WAIT_L(8); PG8_BAR; PG8_WAIT_L(0); PG8_MMA(0, 0, At, B0); PG8_BAR; PG8_SCHED;
            PG8_LDB(B1, 1, 1); PG8_STAGE(PG8_SB(1, 0), b3, voffB);
            PG8_BAR; PG8_WAIT_L(0); PG8_MMA(0, 1, At, B1); PG8_BAR;
            PG8_LDA(At, 1, 1); PG8_STAGE(PG8_SA(1, 0), a3, voffA);
            PG8_BAR; PG8_WAIT_L(0); PG8_MMA(1, 0, At, B0); PG8_BAR; PG8_SCHED;
            PG8_STAGE(PG8_SB(1, 1), b3 + hstep, voffB);
            PG8_WAIT_V(6); PG8_BAR; PG8_MMA(1, 1, At, B1); PG8_BAR;
            }
        }
        if constexpr (ALIGN_EPI) { if (wr == 0) PG8_BAR; }
        if constexpr (!Epi::AFTER_DRAIN) { E(acc, cur, wr, wc, fr, fq); S.done(cur); }
        if (!has_next) break;
#pragma unroll
        for (int a = 0; a < 2; ++a)
#pragma unroll
            for (int b = 0; b < 2; ++b)
#pragma unroll
                for (int m = 0; m < 4; ++m)
#pragma unroll
                    for (int n = 0; n < 2; ++n) acc[a][b][m][n] = (f32x4){0.f, 0.f, 0.f, 0.f};
        cur = nxt; cA = nA; cB = nB; ++ui;
        if constexpr (ALIGN_EPI) { if (wr == 1) PG8_BAR; }
    }
    PG8_WAIT_V(0);
    if constexpr (!ALIGN_EPI) { if (wr == 0) PG8_BAR; }
    PG8_BAR;
    if constexpr (Epi::AFTER_DRAIN) { E.fused(acc, cur, wr, wc, fr, fq, lds, wid, lane); S.done(cur); }
#undef PG8_SA
#undef PG8_SB
#undef PG8_STAGE
#undef PG8_LDA
#undef PG8_LDB
#undef PG8_MMA
#undef PG8_WAIT_V
#undef PG8_WAIT_L
#undef PG8_BAR
#undef PG8_SCHED
}
}

#define LAS __attribute__((address_space(3)))
typedef unsigned short bf16_t;
typedef short bf16x8 __attribute__((ext_vector_type(8)));
typedef float f32x4 __attribute__((ext_vector_type(4)));
typedef unsigned u32x4 __attribute__((ext_vector_type(4)));
typedef unsigned u32x2 __attribute__((ext_vector_type(2)));

constexpr int T_LAT = 32768, T_ALL = 36864, DM = 1024, NP = 2816, DFF = 2816, NMOD = 6144, MIXW = 1280;
constexpr float ALPHA = 1.189207115002721f, LN_EPS = 1e-6f;
constexpr int LDS_BYTES = 147456;
constexpr int NTHREADS = 512;
constexpr size_t OFF_MOD = 4096;
constexpr size_t OFF_ROPE = OFF_MOD + (size_t)17 * NMOD * 4;
constexpr size_t OFF_BTIN = OFF_ROPE + 8192;
constexpr size_t OFF_BTOUT = OFF_BTIN + (size_t)NP * DM * 2;
constexpr size_t OFF_BTGU = OFF_BTOUT + (size_t)DM * MIXW * 2;
constexpr size_t OFF_BTD = OFF_BTGU + (size_t)2 * DFF * DM * 2;
constexpr size_t OFF_DFT = OFF_BTD + (size_t)DM * DFF * 2;
constexpr size_t OFF_U = OFF_DFT + (size_t)4096 * 2048 * 2;
constexpr size_t OFF_P = OFF_U + (size_t)T_ALL * DM * 2;
constexpr size_t OFF_ST = OFF_P + (size_t)T_ALL * NP * 2;
constexpr size_t OFF_SBF = OFF_ST + (size_t)1728 * 2 * 8192 * 4;
constexpr size_t WS_END = OFF_SBF + (size_t)1536 * 2 * 8192 * 2;

struct Params { const float* in[17]; float* out; unsigned char* ws; };
enum { I_X = 0, I_C, I_CTX, I_CCTX, I_WMOD, I_BMOD, I_WIN, I_WOUT, I_DF, I_DB, I_L1G, I_L1B, I_WG, I_WU, I_WD, I_L2G, I_L2B };

__device__ __forceinline__ float bf2f(unsigned v) { return __uint_as_float(v << 16); }
__device__ __forceinline__ unsigned pk2(float lo, float hi) { return pg8::cvt_pk_bf16(lo, hi); }
__device__ __forceinline__ float silu_f(float x) { return x * __builtin_amdgcn_rcpf(1.f + __expf(-x)); }
__device__ __forceinline__ float wave_sum(float v) {
#pragma unroll
    for (int o = 1; o < 64; o <<= 1) v += __shfl_xor(v, o);
    return v;
}
__device__ __forceinline__ float logsig(float x) { return fminf(x, 0.f) - log1pf(expf(-fabsf(x))); }
__device__ __forceinline__ bf16x8 lds_frag(const LAS bf16_t* p) { return *(const LAS bf16x8*)p; }
#define MFMA16(X, Y, ACC) __builtin_amdgcn_mfma_f32_16x16x32_bf16((X), (Y), (ACC), 0, 0, 0)

__device__ __forceinline__ void conv_tile(const float* W, int ldw, int ks0, int c0, int permtype, float scale, bf16_t* dst, int ldd, int j0, int kk0, LAS float* S, int tid) {
#pragma unroll
    for (int i = 0; i < 8; ++i) { const int idx = tid + 512 * i, r = idx >> 6, c = idx & 63; S[r * 65 + c] = W[(size_t)(ks0 + r) * ldw + c0 + c]; }
    __syncthreads();
    const int s = tid >> 3, ch = tid & 7; const int cs = (s & 32) + (permtype ? pg8::perm32(s & 31) : (s & 31));
    float v[8];
#pragma unroll
    for (int i = 0; i < 8; ++i) v[i] = S[(8 * ch + i) * 65 + cs] * scale;
    u32x4 o; o.x = pk2(v[0], v[1]); o.y = pk2(v[2], v[3]); o.z = pk2(v[4], v[5]); o.w = pk2(v[6], v[7]);
    *(u32x4*)(dst + (size_t)(j0 + s) * ldd + kk0 + 8 * ch) = o;
    __syncthreads();
}
__device__ __forceinline__ void fold_tile(const float* Win, int g, int kc, bf16_t* BtIn, LAS float* S, int tid) {
    LAS float* ct = S + 64 * 65; LAS float* st = ct + 64;
#pragma unroll
    for (int i = 0; i < 8; ++i) { const int idx = tid + 512 * i, r = idx >> 6, c = idx & 63; S[r * 65 + c] = Win[(size_t)(64 * kc + r) * 2560 + 64 * g + c]; }
    if (tid < 64) { float sv, cv; sincospif((float)tid * (1.f / 32.f), &sv, &cv); ct[tid] = cv; st[tid] = sv; }
    __syncthreads();
    const int s = tid >> 3, ch = tid & 7; const int cp = (s & 32) + pg8::perm32(s & 31);
    float ac[8], as[8];
#pragma unroll
    for (int i = 0; i < 8; ++i) { ac[i] = 0.f; as[i] = 0.f; }
    for (int c = 0; c < 64; ++c) { const int m = (c * cp) & 63; const float cv = ct[m], sv = st[m];
#pragma unroll
        for (int i = 0; i < 8; ++i) { const float a = S[(8 * ch + i) * 65 + c]; ac[i] += a * cv; as[i] += a * sv; } }
    u32x4 o; o.x = pk2(ac[0] * .125f, ac[1] * .125f); o.y = pk2(ac[2] * .125f, ac[3] * .125f); o.z = pk2(ac[4] * .125f, ac[5] * .125f); o.w = pk2(ac[6] * .125f, ac[7] * .125f);
    *(u32x4*)(BtIn + (size_t)(64 * g + s) * DM + 64 * kc + 8 * ch) = o;
    o.x = pk2(as[0] * .125f, as[1] * .125f); o.y = pk2(as[2] * .125f, as[3] * .125f); o.z = pk2(as[4] * .125f, as[5] * .125f); o.w = pk2(as[6] * .125f, as[7] * .125f);
    *(u32x4*)(BtIn + (size_t)(256 + 64 * g + s) * DM + 64 * kc + 8 * ch) = o;
    __syncthreads();
}
__device__ __forceinline__ void phase0a(const Params& p, LAS unsigned char* lds, int blk, int G, int tid) {
    unsigned char* ws = p.ws;
    LAS float* S = (LAS float*)lds;
    bf16_t* BtIn = (bf16_t*)(ws + OFF_BTIN); bf16_t* BtOut = (bf16_t*)(ws + OFF_BTOUT); bf16_t* BtGU = (bf16_t*)(ws + OFF_BTGU); bf16_t* BtD = (bf16_t*)(ws + OFF_BTD);
    if (blk < 192) {
        LAS float* sl = S; LAS float* red = S + 17 * 1024;
        for (int i = tid; i < 17 * 1024; i += 512) { const int r = i >> 10, k = i & 1023; const float v = r < 16 ? p.in[I_C][r * 1024 + k] : p.in[I_CCTX][k]; sl[i] = v / (1.f + expf(-v)); }
        __syncthreads();
        for (int t = blk; t < 192; t += G) {
            const int c0 = 32 * t, c4 = tid & 7, ks = tid >> 3;
            f32x4 acc[17];
#pragma unroll
            for (int r = 0; r < 17; ++r) acc[r] = (f32x4){0.f, 0.f, 0.f, 0.f};
            for (int kk = 0; kk < 16; ++kk) { const int k = 16 * ks + kk; const f32x4 w = *(const f32x4*)(p.in[I_WMOD] + (size_t)k * NMOD + c0 + 4 * c4);
#pragma unroll
                for (int r = 0; r < 17; ++r) acc[r] += sl[r * 1024 + k] * w; }
#pragma unroll
            for (int r = 0; r < 17; ++r)
#pragma unroll
                for (int j = 0; j < 4; ++j) { float v = acc[r][j]; v += __shfl_xor(v, 8); v += __shfl_xor(v, 16); v += __shfl_xor(v, 32); acc[r][j] = v; }
            const int lane = tid & 63, w = tid >> 6;
            if (lane < 8) {
#pragma unroll
                for (int r = 0; r < 17; ++r)
#pragma unroll
                    for (int j = 0; j < 4; ++j) red[(w * 17 + r) * 32 + 4 * c4 + j] = acc[r][j]; }
            __syncthreads();
            for (int i = tid; i < 17 * 32; i += 512) { const int r = i >> 5, cc = i & 31; float v = p.in[I_BMOD][c0 + cc];
#pragma unroll
                for (int ww = 0; ww < 8; ++ww) v += red[(ww * 17 + r) * 32 + cc];
                ((float*)(ws + OFF_MOD))[r * NMOD + c0 + cc] = v; }
            __syncthreads();
        }
    }
    if (blk == G - 1) {
        for (int i = tid; i < 1024; i += 512) { const int pos = i >> 4, fi = i & 15; const float f = (float)pow(10000.0, -(double)fi / 16.0); const float ang = (float)pos * f;
            double sv, cv; sincospi((double)ang * 0.31830988618379067154, &sv, &cv); ((float*)(ws + OFF_ROPE))[2 * i] = (float)cv; ((float*)(ws + OFF_ROPE))[2 * i + 1] = (float)sv; }
    }
    __syncthreads();
    for (int it = blk; it < 3072; it += G) {
        int r = it;
        if (r < 64) { fold_tile(p.in[I_WIN], r >> 4, r & 15, BtIn, S, tid); continue; } r -= 64;
        if (r < 576) { const int jt = r >> 4, kt = r & 15, jj0 = 64 * jt; conv_tile(p.in[I_WIN], 2560, 64 * kt, 256 + jj0, jj0 < 768 ? 0 : 1, (jj0 >= 384 && jj0 < 768) ? 0.125f : 1.f, BtIn, DM, 512 + jj0, 64 * kt, S, tid); continue; } r -= 576;
        if (r < 320) { const int kt = r >> 4, jt = r & 15, kk0 = 64 * kt; conv_tile(p.in[I_WOUT], 1024, kk0 < 256 ? kk0 : kk0 - 256, 64 * jt, 0, 1.f, BtOut, MIXW, 64 * jt, kk0, S, tid); continue; } r -= 320;
        if (r < 1408) { const int jt = r >> 4, kt = r & 15, pn = jt >> 2, q = jt & 3; conv_tile(q < 2 ? p.in[I_WG] : p.in[I_WU], DFF, 64 * kt, 128 * pn + 64 * (q & 1), 1, 1.f, BtGU, DM, 64 * jt, 64 * kt, S, tid); continue; } r -= 1408;
        { const int kt = r >> 4, jt = r & 15; conv_tile(p.in[I_WD], 1024, 64 * kt, 64 * jt, 0, 1.f, BtD, DFF, 64 * jt, 64 * kt, S, tid); }
    }
    for (int i = tid; i < 2048; i += 512) S[i] = cospif((float)i * (1.f / 1024.f)) * 0.02209708691207961f;
    __syncthreads();
    bf16_t* dft = (bf16_t*)(ws + OFF_DFT);
    for (int t = blk; t < 2048; t += G) {
        const int row = 2 * t + (tid >> 8), n0 = 8 * (tid & 255); const int np = row & 2047, off = row >= 2048 ? 512 : 0;
        float v[8];
#pragma unroll
        for (int i = 0; i < 8; ++i) v[i] = S[(np * (n0 + i) + off) & 2047];
        u32x4 o; o.x = pk2(v[0], v[1]); o.y = pk2(v[2], v[3]); o.z = pk2(v[4], v[5]); o.w = pk2(v[6], v[7]);
        *(u32x4*)(dft + (size_t)row * 2048 + n0) = o;
    }
}

__device__ __forceinline__ void load16(const float* row, int lane, float (&v)[16]) {
    const f32x4 a = *(const f32x4*)(row + 8 * lane), b = *(const f32x4*)(row + 8 * lane + 4), c = *(const f32x4*)(row + 512 + 8 * lane), d = *(const f32x4*)(row + 512 + 8 * lane + 4);
#pragma unroll
    for (int j = 0; j < 4; ++j) { v[j] = a[j]; v[4 + j] = b[j]; v[8 + j] = c[j]; v[12 + j] = d[j]; }
}
__device__ __forceinline__ void store16(float* row, int lane, const float (&v)[16]) {
    *(f32x4*)(row + 8 * lane) = (f32x4){v[0], v[1], v[2], v[3]}; *(f32x4*)(row + 8 * lane + 4) = (f32x4){v[4], v[5], v[6], v[7]};
    *(f32x4*)(row + 512 + 8 * lane) = (f32x4){v[8], v[9], v[10], v[11]}; *(f32x4*)(row + 512 + 8 * lane + 4) = (f32x4){v[12], v[13], v[14], v[15]};
}
__device__ __forceinline__ void store16_bf(bf16_t* row, int lane, const float (&v)[16]) {
    u32x4 o; o.x = pk2(v[0], v[1]); o.y = pk2(v[2], v[3]); o.z = pk2(v[4], v[5]); o.w = pk2(v[6], v[7]); *(u32x4*)(row + 8 * lane) = o;
    o.x = pk2(v[8], v[9]); o.y = pk2(v[10], v[11]); o.z = pk2(v[12], v[13]); o.w = pk2(v[14], v[15]); *(u32x4*)(row + 512 + 8 * lane) = o;
}
__device__ __forceinline__ void ln_norm(float (&v)[16]) {
    float s = 0.f;
#pragma unroll
    for (int i = 0; i < 16; ++i) s += v[i];
    const float mean = wave_sum(s) * (1.f / 1024.f); float s2 = 0.f;
#pragma unroll
    for (int i = 0; i < 16; ++i) { v[i] -= mean; s2 += v[i] * v[i]; }
    const float rstd = 1.f / sqrtf(wave_sum(s2) * (1.f / 1024.f) + LN_EPS);
#pragma unroll
    for (int i = 0; i < 16; ++i) v[i] *= rstd;
}
__device__ __forceinline__ void modulate16(float (&v)[16], const float* sh, const float* sc, int lane) {
    float a[16], b[16]; load16(sh, lane, a); load16(sc, lane, b);
#pragma unroll
    for (int i = 0; i < 16; ++i) v[i] = v[i] * (1.f + b[i]) + a[i];
}
__device__ __forceinline__ void affine16(float (&v)[16], const float* g, const float* be, int lane) {
    float a[16], b[16]; load16(g, lane, a); load16(be, lane, b);
#pragma unroll
    for (int i = 0; i < 16; ++i) v[i] = v[i] * a[i] + b[i];
}
__device__ __forceinline__ void phase0b(const Params& p, int blk, int G, int tid) {
    const int lane = tid & 63, gw = blk * 8 + (tid >> 6); const float* mod = (const float*)(p.ws + OFF_MOD); bf16_t* U = (bf16_t*)(p.ws + OFF_U);
    for (int row = gw; row < T_ALL; row += G * 8) {
        const float* src = row < T_LAT ? p.in[I_X] + (size_t)row * DM : p.in[I_CTX] + (size_t)(row - T_LAT) * DM; const int mr = row < T_LAT ? (row >> 11) : 16;
        float v[16]; load16(src, lane, v); ln_norm(v); modulate16(v, mod + mr * NMOD, mod + mr * NMOD + 1024, lane); store16_bf(U + (size_t)row * DM, lane, v);
    }
}
__device__ __forceinline__ void phase6(const Params& p, int blk, int G, int tid) {
    const int lane = tid & 63, gw = blk * 8 + (tid >> 6); const float* mod = (const float*)(p.ws + OFF_MOD); bf16_t* U2 = (bf16_t*)(p.ws + OFF_U); const float* Y1 = (const float*)(p.ws + OFF_P);
    for (int row = gw; row < T_LAT; row += G * 8) {
        float v[16]; load16(Y1 + (size_t)row * DM, lane, v); ln_norm(v); affine16(v, p.in[I_L1G], p.in[I_L1B], lane); store16(p.out + (size_t)row * DM, lane, v);
        ln_norm(v); const int mr = row >> 11; modulate16(v, mod + mr * NMOD + 3072, mod + mr * NMOD + 4096, lane); store16_bf(U2 + (size_t)row * DM, lane, v);
    }
}
__device__ __forceinline__ void phase9(const Params& p, int blk, int G, int tid) {
    const int lane = tid & 63, gw = blk * 8 + (tid >> 6);
    for (int row = gw; row < T_LAT; row += G * 8) {
        float v[16]; load16(p.out + (size_t)row * DM, lane, v); ln_norm(v); affine16(v, p.in[I_L2G], p.in[I_L2B], lane); store16(p.out + (size_t)row * DM, lane, v);
    }
}
struct SchedIn {
    pg8::StaticOrder so; int G, c;
    __device__ bool next(int i, pg8::Unit& u) const {
        const long L = (long)i * G + c;
        if (L < 1408) return so.next(i, u);
        if (L < 1488) { const int r = (int)L - 1408; u.pm = 128 + r / 5; u.pn = 3 + r % 5; return true; }
        return false;
    }
    __device__ __forceinline__ void a_ready(const pg8::Unit&) const {}
    __device__ __forceinline__ void done(const pg8::Unit&) const {}
};
struct SchedF {
    int G, c;
    __device__ bool next(int i, pg8::Unit& u) const {
        const long L = (long)i * G + c; if (L >= 256) return false;
        const int x = (int)L & 7, ii = (int)L >> 3, b = 2 * x + (ii >> 4), part = (ii >> 3) & 1, pmm = ii & 7;
        u.pm = part * 8 + pmm; u.pn = 2 * b + part; return true;
    }
    __device__ __forceinline__ void a_ready(const pg8::Unit&) const {}
    __device__ __forceinline__ void done(const pg8::Unit&) const {}
};
struct EpiIn {
    static constexpr bool PERM = false, AFTER_DRAIN = false;
    bf16_t* P; const float* rope;
    __device__ __forceinline__ void operator()(const f32x4 (&acc)[2][2][4][2], const pg8::Unit& u, int wr, int wc, int fr, int fq) const {
        const int row0 = u.pm * 256 + wr * 64 + fr; const bool lat = u.pm < 128;
#pragma unroll
        for (int bj = 0; bj < 2; ++bj) {
            const int cb = u.pn * 256 + bj * 128;
            if (cb < 512 || cb >= 1280) {
#pragma unroll
                for (int ai = 0; ai < 2; ++ai)
#pragma unroll
                    for (int m = 0; m < 4; ++m) { const int row = row0 + ai * 128 + m * 16; const f32x4 v0 = acc[ai][bj][m][0], v1 = acc[ai][bj][m][1];
                        u32x4 o; o.x = pk2(v0[0], v0[1]); o.y = pk2(v0[2], v0[3]); o.z = pk2(v1[0], v1[1]); o.w = pk2(v1[2], v1[3]);
                        *(u32x4*)(P + (size_t)row * NP + cb + 32 * wc + 8 * fq) = o; }
            } else {
#pragma unroll
                for (int ai = 0; ai < 2; ++ai)
#pragma unroll
                    for (int m = 0; m < 4; ++m) { const int row = row0 + ai * 128 + m * 16; f32x4 x1 = acc[ai][bj][m][0], x2 = acc[ai][bj][m][1];
                        if (lat) { const int t = row & 2047, pos = (wc & 1) ? (t & 63) : (t >> 6); const f32x4* rp = (const f32x4*)(rope + (pos * 16 + 4 * fq) * 2); const f32x4 r0 = rp[0], r1 = rp[1];
                            const f32x4 cs = (f32x4){r0[0], r0[2], r1[0], r1[2]}, sn = (f32x4){r0[1], r0[3], r1[1], r1[3]};
                            const f32x4 o1 = x1 * cs - x2 * sn, o2 = x1 * sn + x2 * cs; x1 = o1; x2 = o2; }
                        u32x2 a, b; a.x = pk2(x1[0], x1[1]); a.y = pk2(x1[2], x1[3]); b.x = pk2(x2[0], x2[1]); b.y = pk2(x2[2], x2[3]);
                        bf16_t* d = P + (size_t)row * NP + cb + 32 * wc + 4 * fq; *(u32x2*)d = a; *(u32x2*)(d + 16) = b; }
            }
        }
    }
};
struct EpiRes {
    static constexpr bool PERM = false, AFTER_DRAIN = false;
    float* Y; const float* X; const float* gate;
    __device__ __forceinline__ void operator()(const f32x4 (&acc)[2][2][4][2], const pg8::Unit& u, int wr, int wc, int fr, int fq) const {
        const int row0 = u.pm * 256 + wr * 64 + fr, col0 = u.pn * 256 + wc * 32 + 4 * fq; const float* gp = gate + (size_t)(u.pm >> 3) * NMOD + col0;
        f32x4 gv[2][2];
#pragma unroll
        for (int bj = 0; bj < 2; ++bj)
#pragma unroll
            for (int n = 0; n < 2; ++n) gv[bj][n] = *(const f32x4*)(gp + bj * 128 + n * 16);
#pragma unroll
        for (int ai = 0; ai < 2; ++ai)
#pragma unroll
            for (int m = 0; m < 4; ++m) { const size_t ro = (size_t)(row0 + ai * 128 + m * 16) * DM + col0;
#pragma unroll
                for (int bj = 0; bj < 2; ++bj)
#pragma unroll
                    for (int n = 0; n < 2; ++n) { const f32x4 xv = *(const f32x4*)(X + ro + bj * 128 + n * 16); *(f32x4*)(Y + ro + bj * 128 + n * 16) = ALPHA * xv + gv[bj][n] * acc[ai][bj][m][n]; } }
    }
};
struct EpiUp {
    static constexpr bool PERM = false, AFTER_DRAIN = false;
    bf16_t* H;
    __device__ __forceinline__ void operator()(const f32x4 (&acc)[2][2][4][2], const pg8::Unit& u, int wr, int wc, int fr, int fq) const {
        const int row0 = u.pm * 256 + wr * 64 + fr, col0 = u.pn * 128 + wc * 32 + 8 * fq;
#pragma unroll
        for (int ai = 0; ai < 2; ++ai)
#pragma unroll
            for (int m = 0; m < 4; ++m) { float h[8];
#pragma unroll
                for (int n = 0; n < 2; ++n)
#pragma unroll
                    for (int j = 0; j < 4; ++j) h[4 * n + j] = silu_f(acc[ai][0][m][n][j]) * acc[ai][1][m][n][j];
                u32x4 o; o.x = pk2(h[0], h[1]); o.y = pk2(h[2], h[3]); o.z = pk2(h[4], h[5]); o.w = pk2(h[6], h[7]);
                *(u32x4*)(H + (size_t)(row0 + ai * 128 + m * 16) * DFF + col0) = o; }
    }
};
struct EpiF {
    static constexpr bool PERM = false, AFTER_DRAIN = false;
    bf16_t* MIX;
    __device__ __forceinline__ void operator()(const f32x4 (&acc)[2][2][4][2], const pg8::Unit& u, int wr, int wc, int fr, int fq) const {
        const int part = u.pm >> 3, pmm = u.pm & 7, b = u.pn >> 1; const int row0 = b * 2048 + pmm * 256 + wr * 64 + fr, col0 = part * 256 + wc * 32 + 4 * fq;
#pragma unroll
        for (int ai = 0; ai < 2; ++ai)
#pragma unroll
            for (int m = 0; m < 4; ++m) { bf16_t* rp = MIX + (size_t)(row0 + ai * 128 + m * 16) * MIXW + col0;
#pragma unroll
                for (int bj = 0; bj < 2; ++bj)
#pragma unroll
                    for (int n = 0; n < 2; ++n) { const f32x4 v = acc[ai][bj][m][n]; u32x2 o; o.x = pk2(v[0], v[1]); o.y = pk2(v[2], v[3]); *(u32x2*)(rp + bj * 128 + n * 16) = o; } }
    }
};

__device__ __forceinline__ void ft_item(const bf16_t* P, bf16_t* FT, int item, LAS bf16_t* T, int tid) {
    const int ti = item >> 3, ci = item & 7, r0 = 64 * ti, b = r0 >> 11, n0 = r0 & 2047, ch0 = 64 * ci;
    { const int tok = tid >> 3, oct = tid & 7; const u32x4 v = *(const u32x4*)(P + (size_t)(r0 + tok) * NP + ch0 + 8 * oct);
#pragma unroll
      for (int j = 0; j < 4; ++j) { T[(8 * oct + 2 * j) * 66 + tok] = (bf16_t)(v[j] & 0xffffu); T[(8 * oct + 2 * j + 1) * 66 + tok] = (bf16_t)(v[j] >> 16); } }
    __syncthreads();
    { const int ch = tid >> 3, to = tid & 7; const LAS unsigned* s = (const LAS unsigned*)(T + ch * 66 + 8 * to); u32x4 o; o.x = s[0]; o.y = s[1]; o.z = s[2]; o.w = s[3];
      *(u32x4*)(FT + (size_t)(b * 512 + ch0 + ch) * 2048 + n0 + 8 * to) = o; }
    __syncthreads();
}
__device__ __forceinline__ void load_vt(const bf16_t* Pv, LAS bf16_t* Vt, int tid) {
#pragma unroll
    for (int i = 0; i < 4; ++i) { const int idx = tid + 512 * i, l = idx >> 4, oct = idx & 15; const u32x4 v = *(const u32x4*)(Pv + (size_t)l * NP + 8 * oct);
#pragma unroll
        for (int j = 0; j < 4; ++j) { Vt[(8 * oct + 2 * j) * 136 + l] = (bf16_t)(v[j] & 0xffffu); Vt[(8 * oct + 2 * j + 1) * 136 + l] = (bf16_t)(v[j] >> 16); } }
}
__device__ __forceinline__ void state_unit(const Params& p, int u, LAS bf16_t* sm, int tid) {
    const bf16_t* P = (const bf16_t*)(p.ws + OFF_P); float* ST = (float*)(p.ws + OFF_ST);
    int h, R0;
    if (u < 1536) { const int b = u / 96, c = u & 15; h = (u >> 4) % 6; R0 = b * 2048 + 128 * c; }
    else { const int uu = u - 1536, b = uu / 12, c = uu & 1; h = (uu >> 1) % 6; R0 = T_LAT + b * 256 + 128 * c; }
    const float lgf = logsig(p.in[I_DF][h]), lgb = logsig(p.in[I_DB][h]);
    LAS bf16_t* Vt = sm; LAS bf16_t* Kf = Vt + 128 * 136; LAS bf16_t* Kb = Kf + 64 * 136;
    load_vt(P + (size_t)R0 * NP + 1280 + 128 * h, Vt, tid);
#pragma unroll
    for (int i = 0; i < 2; ++i) { const int idx = tid + 512 * i, l = idx >> 3, oct = idx & 7; const u32x4 v = *(const u32x4*)(P + (size_t)(R0 + l) * NP + 896 + 64 * h + 8 * oct);
        const float zf = __expf(lgf * (float)(127 - l)), zb = __expf(lgb * (float)l);
#pragma unroll
        for (int j = 0; j < 4; ++j) { const float k0 = bf2f(v[j] & 0xffffu), k1 = bf2f(v[j] >> 16); const unsigned f2 = pk2(k0 * zf, k1 * zf), b2 = pk2(k0 * zb, k1 * zb);
            Kf[(8 * oct + 2 * j) * 136 + l] = (bf16_t)(f2 & 0xffffu); Kf[(8 * oct + 2 * j + 1) * 136 + l] = (bf16_t)(f2 >> 16);
            Kb[(8 * oct + 2 * j) * 136 + l] = (bf16_t)(b2 & 0xffffu); Kb[(8 * oct + 2 * j + 1) * 136 + l] = (bf16_t)(b2 >> 16); } }
    __syncthreads();
    const int w = tid >> 6, lane = tid & 63, fr = lane & 15, q = lane >> 4;
#pragma unroll
    for (int dir = 0; dir < 2; ++dir) { const LAS bf16_t* Kz = dir ? Kb : Kf; f32x4 acc[4];
#pragma unroll
        for (int dt = 0; dt < 4; ++dt) acc[dt] = (f32x4){0.f, 0.f, 0.f, 0.f};
#pragma unroll
        for (int ks = 0; ks < 4; ++ks) { const bf16x8 y = lds_frag(Vt + (16 * w + fr) * 136 + 32 * ks + 8 * q);
#pragma unroll
            for (int dt = 0; dt < 4; ++dt) acc[dt] = MFMA16(lds_frag(Kz + (16 * dt + fr) * 136 + 32 * ks + 8 * q), y, acc[dt]); }
        float* o = ST + ((size_t)(u * 2 + dir) * 128 + 16 * w + fr) * 64 + 4 * q;
#pragma unroll
        for (int dt = 0; dt < 4; ++dt) *(f32x4*)(o + 16 * dt) = acc[dt]; }
    __syncthreads();
}
__device__ __forceinline__ void phase2(const Params& p, LAS unsigned char* lds, int blk, int G, int tid) {
    const bf16_t* P = (const bf16_t*)(p.ws + OFF_P); bf16_t* FT = (bf16_t*)(p.ws + OFF_U);
    for (int it = blk; it < 4096; it += G) ft_item(P, FT, it, (LAS bf16_t*)lds, tid);
    for (int u = blk; u < 1728; u += G) state_unit(p, u, (LAS bf16_t*)lds, tid);
}
__device__ __forceinline__ void phase3(const Params& p, int blk, int G, int tid) {
    const float* ST = (const float*)(p.ws + OFF_ST); bf16_t* SBF = (bf16_t*)(p.ws + OFF_SBF);
    for (int it = blk * NTHREADS + tid; it < 96 * 2 * 2048; it += G * NTHREADS) {
        const int e4 = it & 2047, dir = (it >> 11) & 1, bh = it >> 12, h = bh % 6;
        const float lg = logsig(dir ? p.in[I_DB][h] : p.in[I_DF][h]), g128 = expf(lg * 128.f);
        const f32x4 c0 = *(const f32x4*)(ST + ((size_t)(1536 + bh * 2) * 2 + dir) * 8192 + 4 * e4), c1 = *(const f32x4*)(ST + ((size_t)(1536 + bh * 2 + 1) * 2 + dir) * 8192 + 4 * e4);
        f32x4 s = dir ? (c0 + g128 * c1) : (g128 * c0 + c1);
        for (int i = 0; i < 16; ++i) { const int c = dir ? 15 - i : i; const size_t o = ((size_t)(bh * 16 + c) * 2 + dir) * 8192 + 4 * e4;
            u32x2 w; w.x = pk2(s[0], s[1]); w.y = pk2(s[2], s[3]); *(u32x2*)(SBF + o) = w;
            s = g128 * s + *(const f32x4*)(ST + o); }
    }
}
__device__ __forceinline__ void ret_unit(const Params& p, int u, LAS bf16_t* sm, int tid) {
    const bf16_t* P = (const bf16_t*)(p.ws + OFF_P); const bf16_t* SBF = (const bf16_t*)(p.ws + OFF_SBF); bf16_t* MIX = (bf16_t*)(p.ws + OFF_ST);
    const int b = u / 96, c = u & 15, h = (u >> 4) % 6, R0 = b * 2048 + 128 * c;
    const float lgf = logsig(p.in[I_DF][h]), lgb = logsig(p.in[I_DB][h]);
    LAS bf16_t* Qs = sm; LAS bf16_t* Ks = Qs + 128 * 72; LAS bf16_t* Ps = Ks + 128 * 72; LAS bf16_t* Vt = Ps + 128 * 136; LAS bf16_t* Sf = Vt + 128 * 136; LAS bf16_t* Sb = Sf + 128 * 72;
#pragma unroll
    for (int i = 0; i < 2; ++i) { const int idx = tid + 512 * i, l = idx >> 3, oct = idx & 7; const bf16_t* src = P + (size_t)(R0 + l) * NP + 64 * h + 8 * oct;
        *(LAS u32x4*)(Qs + l * 72 + 8 * oct) = *(const u32x4*)(src + 512); *(LAS u32x4*)(Ks + l * 72 + 8 * oct) = *(const u32x4*)(src + 896);
        *(LAS u32x4*)(Sf + l * 72 + 8 * oct) = *(const u32x4*)(SBF + (size_t)(u * 2) * 8192 + idx * 8); *(LAS u32x4*)(Sb + l * 72 + 8 * oct) = *(const u32x4*)(SBF + (size_t)(u * 2 + 1) * 8192 + idx * 8); }
    load_vt(P + (size_t)R0 * NP + 1280 + 128 * h, Vt, tid);
    __syncthreads();
    const int w = tid >> 6, lane = tid & 63, fr = lane & 15, q = lane >> 4, ci = 16 * w + fr;
    bf16x8 yq[2]; yq[0] = lds_frag(Qs + ci * 72 + 8 * q); yq[1] = lds_frag(Qs + ci * 72 + 32 + 8 * q);
#pragma unroll
    for (int lt = 0; lt < 8; ++lt) { f32x4 a = (f32x4){0.f, 0.f, 0.f, 0.f};
        a = MFMA16(lds_frag(Ks + (16 * lt + fr) * 72 + 8 * q), yq[0], a); a = MFMA16(lds_frag(Ks + (16 * lt + fr) * 72 + 32 + 8 * q), yq[1], a);
        float pv[4];
#pragma unroll
        for (int j = 0; j < 4; ++j) { const int d = ci - (16 * lt + 4 * q + j); pv[j] = a[j] * __expf(d >= 0 ? lgf * (float)d : -lgb * (float)d); }
        u32x2 o; o.x = pk2(pv[0], pv[1]); o.y = pk2(pv[2], pv[3]); *(LAS u32x2*)(Ps + ci * 136 + 16 * lt + 4 * q) = o; }
    __syncthreads();
    f32x4 ai[8], af[8], ab[8];
#pragma unroll
    for (int et = 0; et < 8; ++et) { ai[et] = (f32x4){0.f, 0.f, 0.f, 0.f}; af[et] = ai[et]; ab[et] = ai[et]; }
#pragma unroll
    for (int ks = 0; ks < 4; ++ks) { const bf16x8 y = lds_frag(Ps + ci * 136 + 32 * ks + 8 * q);
#pragma unroll
        for (int et = 0; et < 8; ++et) ai[et] = MFMA16(lds_frag(Vt + (16 * et + fr) * 136 + 32 * ks + 8 * q), y, ai[et]); }
#pragma unroll
    for (int ks = 0; ks < 2; ++ks) {
#pragma unroll
        for (int et = 0; et < 8; ++et) { af[et] = MFMA16(lds_frag(Sf + (16 * et + fr) * 72 + 32 * ks + 8 * q), yq[ks], af[et]); ab[et] = MFMA16(lds_frag(Sb + (16 * et + fr) * 72 + 32 * ks + 8 * q), yq[ks], ab[et]); } }
    const float xf = __expf(lgf * (float)(ci + 1)), xb = __expf(lgb * (float)(128 - ci)); float ss = 0.f;
#pragma unroll
    for (int et = 0; et < 8; ++et) { ai[et] = ai[et] + xf * af[et] + xb * ab[et]; ss += ai[et][0] * ai[et][0] + ai[et][1] * ai[et][1] + ai[et][2] * ai[et][2] + ai[et][3] * ai[et][3]; }
    ss += __shfl_xor(ss, 16); ss += __shfl_xor(ss, 32);
    const float rn = 1.f / sqrtf(ss * (1.f / 128.f) + LN_EPS);
    const bf16_t* gp = P + (size_t)(R0 + ci) * NP + 2048 + 128 * h + 4 * q; bf16_t* op = MIX + (size_t)(R0 + ci) * MIXW + 512 + 128 * h + 4 * q;
#pragma unroll
    for (int et = 0; et < 8; ++et) { const u32x2 gv = *(const u32x2*)(gp + 16 * et);
        const float g0 = bf2f(gv.x & 0xffffu), g1 = bf2f(gv.x >> 16), g2 = bf2f(gv.y & 0xffffu), g3 = bf2f(gv.y >> 16);
        u32x2 o; o.x = pk2(ai[et][0] * rn * silu_f(g0), ai[et][1] * rn * silu_f(g1)); o.y = pk2(ai[et][2] * rn * silu_f(g2), ai[et][3] * rn * silu_f(g3));
        *(u32x2*)(op + 16 * et) = o; }
    __syncthreads();
}

__global__ __launch_bounds__(512, 2) void fwd_megakernel(Params p) {
    extern __shared__ __attribute__((aligned(16))) unsigned char shm[];
    LAS unsigned char* lds = (LAS unsigned char*)shm;
    cg::grid_group grid = cg::this_grid();
    const int tid = threadIdx.x, blk = blockIdx.x, G = gridDim.x;
    unsigned char* ws = p.ws;
    phase0a(p, lds, blk, G, tid);
    grid.sync();
    phase0b(p, blk, G, tid);
    grid.sync();
    {
        pg8::Gemm g{(const bf16_t*)(ws + OFF_U), (const bf16_t*)(ws + OFF_BTIN), T_ALL, NP, DM};
        SchedIn S; S.so.init(T_LAT, NP, G, blk); S.G = G; S.c = blk;
        EpiIn E{(bf16_t*)(ws + OFF_P), (const float*)(ws + OFF_ROPE)};
        pg8::gemm_phase<EpiIn, SchedIn, true, true>(lds, g, S, E);
    }
    grid.sync();
    phase2(p, lds, blk, G, tid);
    grid.sync();
    phase3(p, blk, G, tid);
    grid.sync();
    {
        pg8::Gemm g{(const bf16_t*)(ws + OFF_DFT), (const bf16_t*)(ws + OFF_U), 4096, 8192, 2048};
        SchedF S{G, blk}; EpiF E{(bf16_t*)(ws + OFF_ST)};
        pg8::gemm_phase<EpiF, SchedF, true, true>(lds, g, S, E);
        __syncthreads();
        for (int u = blk; u < 1536; u += G) ret_unit(p, u, (LAS bf16_t*)lds, tid);
    }
    grid.sync();
    {
        pg8::Gemm g{(const bf16_t*)(ws + OFF_ST), (const bf16_t*)(ws + OFF_BTOUT), T_LAT, DM, MIXW};
        pg8::StaticOrder S; S.init(T_LAT, DM, G, blk);
        EpiRes E{(float*)(ws + OFF_P), p.in[I_X], (const float*)(ws + OFF_MOD) + 2048};
        pg8::gemm_phase<EpiRes, pg8::StaticOrder, true, true>(lds, g, S, E);
    }
    grid.sync();
    phase6(p, blk, G, tid);
    grid.sync();
    {
        pg8::Gemm g{(const bf16_t*)(ws + OFF_U), (const bf16_t*)(ws + OFF_BTGU), T_LAT, 2 * DFF, DM};
        pg8::StaticOrder S; S.init(T_LAT, 2 * DFF, G, blk);
        EpiUp E{(bf16_t*)(ws + OFF_P)};
        pg8::gemm_phase<EpiUp, pg8::StaticOrder, true, true>(lds, g, S, E);
    }
    grid.sync();
    {
        pg8::Gemm g{(const bf16_t*)(ws + OFF_P), (const bf16_t*)(ws + OFF_BTD), T_LAT, DM, DFF};
        pg8::StaticOrder S; S.init(T_LAT, DM, G, blk);
        EpiRes E{p.out, p.out, (const float*)(ws + OFF_MOD) + 5120};
        pg8::gemm_phase<EpiRes, pg8::StaticOrder, true, true>(lds, g, S, E);
    }
    grid.sync();
    phase9(p, blk, G, tid);
}

extern "C" void kernel_launch(void* const* d_in, const int* in_sizes, int n_in, void* d_out, int out_size, void* d_ws, size_t ws_size, hipStream_t stream) {
    static int grid = 0;
    if (grid == 0) {
        if (n_in != 17 || out_size != T_LAT * DM || ws_size < WS_END) { fprintf(stderr, "kernel_launch: unexpected shapes (n_in %d, out %d, ws %zu < %zu)\n", n_in, out_size, ws_size, (size_t)WS_END); grid = -1; return; }
        int dev = 0, cus = 0, per_cu = 0;
        hipGetDevice(&dev); hipDeviceGetAttribute(&cus, hipDeviceAttributeMultiprocessorCount, dev);
        if (hipFuncSetAttribute((const void*)fwd_megakernel, hipFuncAttributeMaxDynamicSharedMemorySize, LDS_BYTES) != hipSuccess) { fprintf(stderr, "kernel_launch: hipFuncSetAttribute failed\n"); grid = -1; return; }
        if (hipOccupancyMaxActiveBlocksPerMultiprocessor(&per_cu, (const void*)fwd_megakernel, NTHREADS, LDS_BYTES) != hipSuccess || per_cu < 1) { fprintf(stderr, "kernel_launch: occupancy query failed (%d)\n", per_cu); grid = -1; return; }
        grid = cus * per_cu;
    }
    if (grid < 0) return;
    Params p{};
    for (int i = 0; i < 17; ++i) p.in[i] = (const float*)d_in[i];
    p.out = (float*)d_out; p.ws = (unsigned char*)d_ws;
    void* args[] = {&p};
    hipError_t e = hipLaunchCooperativeKernel((const void*)fwd_megakernel, dim3(grid), dim3(NTHREADS), args, LDS_BYTES, stream);
    if (e != hipSuccess) fprintf(stderr, "kernel_launch: cooperative launch failed: %s (grid %d)\n", hipGetErrorString(e), grid);
}
```

```cpp
#include <hip/hip_runtime.h>
#include <hip/hip_cooperative_groups.h>
#include <cstdio>
#include <cstdint>
namespace cg = cooperative_groups;
namespace pg8 {
#define PG8_LAS __attribute__((address_space(3)))
typedef unsigned short bf16_t;
typedef short bf16x8 __attribute__((ext_vector_type(8)));
typedef float f32x4 __attribute__((ext_vector_type(4)));
typedef unsigned u32x4 __attribute__((ext_vector_type(4)));
constexpr int BM = 256, BK = 64, HALF = 128, HTB = HALF * BK * 2  , STAGE_BYTES = 8 * HTB, NXCD = 8, WGM = 8;

__host__ __device__ __forceinline__ int lds_byte(int r, int c) { const int st = (r >> 4) * 2 + (c >> 5), rr = r & 15, cc = c & 31, ob = rr * 64 + cc * 2; return st * 1024 + (ob ^ (((ob >> 9) & 1) << 5)); }
__host__ __device__ __forceinline__ void stage_rc(int b, int& R, int& C) { const int st = b / 1024, sb = b % 1024, swz = sb ^ (((sb >> 9) & 1) << 5); R = (st >> 1) * 16 + swz / 64; C = (st & 1) * 32 + (swz % 64) / 2; }
__host__ __device__ __forceinline__ int perm32(int rho) { const int n = rho >> 4, i = rho & 15; return 8 * (i >> 2) + 4 * n + (i & 3); }

struct Unit { int pm, pn; };
struct Gemm { const bf16_t* A; const bf16_t* Bt; int M, N, K; };

struct StaticOrder {
    int nM, nN, nwg, G, c;
    __host__ __device__ void init(int M, int N, int G_, int c_) { nM = M / BM; nN = N / BM; nwg = nM * nN; G = G_; c = c_; }
    __host__ __device__ bool next(int i, Unit& u) const {
        const long L = (long)i * G + c; if (L >= nwg) return false;
        int wgid = (int)L; { const int q = nwg / NXCD, r = nwg % NXCD, xcd = wgid % NXCD, off = wgid / NXCD; wgid = (xcd < r ? xcd * (q + 1) : r * (q + 1) + (xcd - r) * q) + off; }
        const int nig = WGM * nN, gid = wgid / nig, fm = gid * WGM, gsz = (nM - fm) < WGM ? (nM - fm) : WGM;
        u.pm = fm + ((wgid % nig) % gsz); u.pn = (wgid % nig) / gsz; return true;
    }
    __device__ __forceinline__ void a_ready(const Unit&) const {}
    __device__ __forceinline__ void done(const Unit&) const {}
};
__device__ __forceinline__ unsigned cvt_pk_bf16(float lo, float hi) { unsigned r; asm volatile("v_cvt_pk_bf16_f32 %0, %1, %2" : "=v"(r) : "v"(lo), "v"(hi)); return r; }
typedef float f32x2 __attribute__((ext_vector_type(2)));
template <class Epi, class Sched, bool ALIGN_EPI = false, bool SP2 = false>
__device__ __forceinline__ void gemm_phase(PG8_LAS unsigned char* lds, const Gemm g, const Sched& S, const Epi& E) {
    const int tid = threadIdx.x, wid = __builtin_amdgcn_readfirstlane(tid >> 6), lane = tid & 63, wr = wid >> 2, wc = wid & 3, fr = lane & 15, fq = lane >> 4;
    const int K = g.K, nt = K / BK;
    unsigned voffA[2], voffB[2];
#pragma unroll
    for (int i = 0; i < 2; ++i) { int R, C; stage_rc(tid * 16 + i * 8192, R, C); const int Rb = Epi::PERM ? ((R & ~31) + perm32(R & 31)) : R;
        voffA[i] = (unsigned)(R * K + C) * 2u; voffB[i] = (unsigned)(Rb * K + C) * 2u; }
    const size_t kstep = (size_t)(BK * 2);
    const size_t hstep = (size_t)HALF * K * 2;
    const size_t tstep = 2 * hstep;
    const unsigned ldsw = (unsigned)wid * 1024u;
    const int aoff = lds_byte(wr * 64 + fr, fq * 8), boff = lds_byte(wc * 32 + fr, fq * 8);
#define PG8_SA(b, h) (((b) * 2 + (h)) * HTB)
#define PG8_SB(b, h) ((4 + (b) * 2 + (h)) * HTB)
#define PG8_STAGE(bufoff, gbase, voff) do { _Pragma("unroll") for (int _i = 0; _i < 2; ++_i) \
        __builtin_amdgcn_global_load_lds((const unsigned*)((const char*)(gbase) + (voff)[_i]), (PG8_LAS unsigned*)(lds + (bufoff) + ldsw + _i * 8192), 16, 0, 0); } while (0)
#define PG8_LDA(dst, b, h) do { _Pragma("unroll") for (int m = 0; m < 4; ++m) _Pragma("unroll") for (int k = 0; k < 2; ++k) dst[m][k] = *(const PG8_LAS bf16x8*)(lds + PG8_SA(b, h) + aoff + m * 2048 + k * 1024); } while (0)
#define PG8_LDB(dst, b, h) do { _Pragma("unroll") for (int n = 0; n < 2; ++n) _Pragma("unroll") for (int k = 0; k < 2; ++k) dst[n][k] = *(const PG8_LAS bf16x8*)(lds + PG8_SB(b, h) + boff + n * 2048 + k * 1024); } while (0)
#define PG8_MMA(ai, bj, At, Bt) do { __builtin_amdgcn_s_setprio(1); _Pragma("unroll") for (int m = 0; m < 4; ++m) _Pragma("unroll") for (int n = 0; n < 2; ++n) _Pragma("unroll") for (int k = 0; k < 2; ++k) \
        acc[ai][bj][m][n] = __builtin_amdgcn_mfma_f32_16x16x32_bf16(Bt[n][k], At[m][k], acc[ai][bj][m][n], 0, 0, 0); __builtin_amdgcn_s_setprio(0); } while (0)
#define PG8_WAIT_V(n) asm volatile("s_waitcnt vmcnt(" #n ")" ::: "memory")
#define PG8_WAIT_L(n) asm volatile("s_waitcnt lgkmcnt(" #n ")" ::: "memory")
#define PG8_BAR __builtin_amdgcn_s_barrier()
#define PG8_SCHED __builtin_amdgcn_sched_barrier(0)
    Unit cur, nxt; int ui = 0;
    if (!S.next(0, cur)) return;
    f32x4 acc[2][2][4][2];
#pragma unroll
    for (int a = 0; a < 2; ++a)
#pragma unroll
        for (int b = 0; b < 2; ++b)
#pragma unroll
            for (int m = 0; m < 4; ++m)
#pragma unroll
                for (int n = 0; n < 2; ++n) acc[a][b][m][n] = (f32x4){0.f, 0.f, 0.f, 0.f};
    bf16x8 At[4][2], B0[2][2], B1[2][2];
    const char* cA = (const char*)g.A + (size_t)cur.pm * tstep; const char* cB = (const char*)g.Bt + (size_t)cur.pn * tstep;
    S.a_ready(cur);
    if constexpr (SP2) {
        PG8_STAGE(PG8_SB(0, 0), cB, voffB); PG8_STAGE(PG8_SB(0, 1), cB + hstep, voffB); PG8_STAGE(PG8_SA(0, 0), cA, voffA); PG8_STAGE(PG8_SA(0, 1), cA + hstep, voffA);
        if (wr == 1) PG8_BAR;
        PG8_WAIT_V(2); PG8_BAR;
        PG8_STAGE(PG8_SB(1, 0), cB + kstep, voffB); PG8_STAGE(PG8_SA(1, 0), cA + kstep, voffA); PG8_STAGE(PG8_SB(1, 1), cB + hstep + kstep, voffB);
        PG8_WAIT_V(6); PG8_BAR;
    } else {
        PG8_STAGE(PG8_SB(0, 0), cB, voffB); PG8_STAGE(PG8_SA(0, 0), cA, voffA); PG8_STAGE(PG8_SB(0, 1), cB + hstep, voffB); PG8_STAGE(PG8_SA(0, 1), cA + hstep, voffA);
        if (wr == 1) PG8_BAR;
        PG8_WAIT_V(4); PG8_BAR;
        PG8_STAGE(PG8_SB(1, 0), cB + kstep, voffB); PG8_STAGE(PG8_SA(1, 0), cA + kstep, voffA); PG8_STAGE(PG8_SB(1, 1), cB + hstep + kstep, voffB);
        PG8_WAIT_V(6); PG8_BAR;
    }
    for (;;) {
        const bool has_next = S.next(ui + 1, nxt);
        const char* nA = has_next ? (const char*)g.A + (size_t)nxt.pm * tstep : cA; const char* nB = has_next ? (const char*)g.Bt + (size_t)nxt.pn * tstep : cB;
        for (int t = 0; t < nt; t += 2) {
            const bool last = (t == nt - 2);
            const char* a1 = cA + (size_t)(t + 1) * kstep;
            const char* a2 = last ? nA : cA + (size_t)(t + 2) * kstep; const char* b2 = last ? nB : cB + (size_t)(t + 2) * kstep;
            const char* a3 = a2 + kstep; const char* b3 = b2 + kstep;
            if (last && has_next) S.a_ready(nxt);
            if constexpr (SP2) {
            PG8_LDB(B0, 0, 0); PG8_LDB(B1, 0, 1); PG8_SCHED; PG8_LDA(At, 0, 0); PG8_STAGE(PG8_SA(1, 1), a1 + hstep, voffA);
            PG8_WAIT_V(8); PG8_WAIT_L(0); PG8_BAR; PG8_MMA(0, 0, At, B0); PG8_MMA(0, 1, At, B1); PG8_BAR; PG8_SCHED;
            PG8_LDA(At, 0, 1); PG8_STAGE(PG8_SB(0, 0), b2, voffB); PG8_STAGE(PG8_SB(0, 1), b2 + hstep, voffB); PG8_STAGE(PG8_SA(0, 0), a2, voffA);
            PG8_WAIT_V(8); PG8_WAIT_L(0); PG8_BAR; PG8_MMA(1, 0, At, B0); PG8_MMA(1, 1, At, B1); PG8_BAR; PG8_SCHED;
            PG8_LDB(B0, 1, 0); PG8_LDB(B1, 1, 1); PG8_SCHED; PG8_LDA(At, 1, 0); PG8_STAGE(PG8_SA(0, 1), a2 + hstep, voffA);
            PG8_WAIT_V(8); PG8_WAIT_L(0); PG8_BAR; PG8_MMA(0, 0, At, B0); PG8_MMA(0, 1, At, B1); PG8_BAR; PG8_SCHED;
            PG8_LDA(At, 1, 1); PG8_STAGE(PG8_SB(1, 0), b3, voffB); PG8_STAGE(PG8_SB(1, 1), b3 + hstep, voffB); PG8_STAGE(PG8_SA(1, 0), a3, voffA);
            PG8_WAIT_V(8); PG8_WAIT_L(0); PG8_BAR; PG8_MMA(1, 0, At, B0); PG8_MMA(1, 1, At, B1); PG8_BAR; PG8_SCHED;
            } else {
            PG8_LDB(B0, 0, 0); PG8_SCHED; PG8_LDA(At, 0, 0); PG8_STAGE(PG8_SA(1, 1), a1 + hstep, voffA);
            PG8_WAIT_L(8); PG8_BAR; PG8_WAIT_L(0); PG8_MMA(0, 0, At, B0); PG8_BAR; PG8_SCHED;
            PG8_LDB(B1, 0, 1); PG8_STAGE(PG8_SB(0, 0), b2, voffB);
            PG8_BAR; PG8_WAIT_L(0); PG8_MMA(0, 1, At, B1); PG8_BAR;
            PG8_LDA(At, 0, 1); PG8_STAGE(PG8_SA(0, 0), a2, voffA);
            PG8_BAR; PG8_WAIT_L(0); PG8_MMA(1, 0, At, B0); PG8_BAR; PG8_SCHED;
            PG8_STAGE(PG8_SB(0, 1), b2 + hstep, voffB);
            PG8_WAIT_V(6); PG8_BAR; PG8_MMA(1, 1, At, B1); PG8_BAR;
            PG8_LDB(B0, 1, 0); PG8_SCHED; PG8_LDA(At, 1, 0); PG8_STAGE(PG8_SA(0, 1), a2 + hstep, voffA);
            PG8_WAIT_L(8); PG8_BAR; PG8_WAIT_L(0); PG8_MMA(0, 0, At, B0); PG8_BAR; PG8_SCHED;
            PG8_LDB(B1, 1, 1); PG8_STAGE(PG8_SB(1, 0), b3, voffB);
            PG8_BAR; PG8_WAIT_L(0); PG8_MMA(0, 1, At, B1); PG8_BAR;
            PG8_LDA(At, 1, 1); PG8_STAGE(PG8_SA(1, 0), a3, voffA);
            PG8_BAR; PG8_WAIT_L(0); PG8_MMA(1, 0, At, B0); PG8_BAR; PG8_SCHED;
            PG8_STAGE(PG8_SB(1, 1), b3 + hstep, voffB);
            PG8_WAIT_V(6); PG8_BAR; PG8_MMA(1, 1, At, B1); PG8_BAR;
            }
        }
        if constexpr (ALIGN_EPI) { if (wr == 0) PG8_BAR; }
        if constexpr (!Epi::AFTER_DRAIN) { E(acc, cur, wr, wc, fr, fq); S.done(cur); }
        if (!has_next) break;
#pragma unroll
        for (int a = 0; a < 2; ++a)
#pragma unroll
            for (int b = 0; b < 2; ++b)
#pragma unroll
                for (int m = 0; m < 4; ++m)
#pragma unroll
                    for (int n = 0; n < 2; ++n) acc[a][b][m][n] = (f32x4){0.f, 0.f, 0.f, 0.f};
        cur = nxt; cA = nA; cB = nB; ++ui;
        if constexpr (ALIGN_EPI) { if (wr == 1) PG8_BAR; }
    }
    PG8_WAIT_V(0);
    if constexpr (!ALIGN_EPI) { if (wr == 0) PG8_BAR; }
    PG8_BAR;
    if constexpr (Epi::AFTER_DRAIN) { E.fused(acc, cur, wr, wc, fr, fq, lds, wid, lane); S.done(cur); }
#undef PG8_SA
#undef PG8_SB
#undef PG8_STAGE
#undef PG8_LDA
#undef PG8_LDB
#undef PG8_MMA
#undef PG8_WAIT_V
#undef PG8_WAIT_L
#undef PG8_BAR
#undef PG8_SCHED
}
}

#define LAS __attribute__((address_space(3)))
typedef unsigned short bf16_t;
typedef short bf16x8 __attribute__((ext_vector_type(8)));
typedef float f32x4 __attribute__((ext_vector_type(4)));
typedef unsigned u32x4 __attribute__((ext_vector_type(4)));
typedef unsigned u32x2 __attribute__((ext_vector_type(2)));

constexpr int T_LAT = 32768, T_ALL = 36864, DM = 1024, NP = 2816, DFF = 2816, NMOD = 6144, MIXW = 1280;
constexpr float ALPHA = 1.189207115002721f, LN_EPS = 1e-6f;
constexpr int LDS_BYTES = 147456;
constexpr int NTHREADS = 512;
constexpr size_t OFF_MOD = 16384;
constexpr size_t OFF_ROPE = OFF_MOD + (size_t)17 * NMOD * 4;
constexpr size_t OFF_BTIN = OFF_ROPE + 8192;
constexpr size_t OFF_BTOUT = OFF_BTIN + (size_t)NP * DM * 2;
constexpr size_t OFF_BTGU = OFF_BTOUT + (size_t)DM * MIXW * 2;
constexpr size_t OFF_BTD = OFF_BTGU + (size_t)2 * DFF * DM * 2;
constexpr size_t OFF_DFT = OFF_BTD + (size_t)DM * DFF * 2;
constexpr size_t OFF_U = OFF_DFT + (size_t)4096 * 2048 * 2;
constexpr size_t OFF_P = OFF_U + (size_t)T_ALL * DM * 2;
constexpr size_t OFF_ST = OFF_P + (size_t)T_ALL * NP * 2;
constexpr size_t OFF_SBF = OFF_ST + (size_t)1728 * 2 * 8192 * 4;
constexpr size_t WS_END = OFF_SBF + (size_t)1536 * 2 * 8192 * 2;

#define XB_TMO      128
#define XB_XCNT(j)  (256  + 64 * (j))
#define XB_XSUB(j)  (1280 + 64 * (j))
#define XB_XGEN(j)  (2304 + 64 * (j))
#define XB_TOP      3328
#define XB_TOPGEN   3392
#define XCD_BAR_WORDS 3456
#define XB_SPIN_CAP (1u << 18)

__device__ __forceinline__ unsigned xb_ld(unsigned* p)              { return __hip_atomic_load(p, __ATOMIC_RELAXED, __HIP_MEMORY_SCOPE_AGENT); }
__device__ __forceinline__ unsigned xb_add(unsigned* p, unsigned v) { return __hip_atomic_fetch_add(p, v, __ATOMIC_RELAXED, __HIP_MEMORY_SCOPE_AGENT); }
__device__ __forceinline__ unsigned xb_xcc_id() { return (unsigned)__builtin_amdgcn_s_getreg((3 << 11) | 20) & 0xFu; }
#define XB_SPIN(cond, bar) do { unsigned _sp = 0; while (cond) { __builtin_amdgcn_s_sleep(1); \
    if ((++_sp & 255u) == 0u) { if (xb_ld(&(bar)[XB_TMO])) break; if (_sp > XB_SPIN_CAP) { atomicAdd(&(bar)[XB_TMO], 1u); break; } } } } while (0)

struct XcdBarrier {
    unsigned* bar; unsigned x;
    volatile LAS unsigned* st;
};

__device__ __forceinline__ XcdBarrier xcd_barrier_post(unsigned* bar, volatile LAS unsigned* st) {
    XcdBarrier b; b.bar = bar; b.x = xb_xcc_id(); b.st = st;
    if (threadIdx.x == 0) (void)xb_add(&bar[XB_XCNT(b.x)], 1u);
    return b;
}
__device__ __forceinline__ void xcd_barrier_complete(unsigned* bar, unsigned x, unsigned& nloc, unsigned& nx) {
    const unsigned G = gridDim.x * gridDim.y * gridDim.z;
    unsigned sum, cnt, mine, sp = 0u;
    for (;;) {
        sum = 0u; cnt = 0u; mine = 0u;
#pragma unroll
        for (unsigned j = 0; j < 16; ++j) { const unsigned c = xb_ld(&bar[XB_XCNT(j)]); sum += c; cnt += (c > 0u) ? 1u : 0u; mine = (j == x) ? c : mine; }
        if (sum == G) break;
        __builtin_amdgcn_s_sleep(1);
        if ((++sp & 255u) == 0u) { if (xb_ld(&bar[XB_TMO])) break; if (sp > XB_SPIN_CAP) { atomicAdd(&bar[XB_TMO], 1u); break; } }
    }
    nloc = mine > 0u ? mine : 1u; nx = cnt > 0u ? cnt : 1u;
}

__device__ __forceinline__ void xcd_barrier(const XcdBarrier& b) {
    asm volatile("s_waitcnt vmcnt(0)" ::: "memory");
    __syncthreads();
    if (threadIdx.x == 0) {
        unsigned* bar = b.bar;
        __builtin_amdgcn_s_waitcnt(0);
        unsigned nloc = b.st[0], nx = b.st[1];
        if (nloc == 0u) { xcd_barrier_complete(bar, b.x, nloc, nx); b.st[0] = nloc; b.st[1] = nx; }
        const unsigned old = xb_add(&bar[XB_XSUB(b.x)], 1u);
        const unsigned gen = old / nloc;
        if (old + 1u == (gen + 1u) * nloc) {
            __builtin_amdgcn_fence(__ATOMIC_RELEASE, "agent");
            asm volatile("s_waitcnt vmcnt(0)" ::: "memory");
            const unsigned og = xb_add(&bar[XB_TOP], 1u);
            const unsigned tg = og / nx;
            if (og + 1u == (tg + 1u) * nx) xb_add(&bar[XB_TOPGEN], 1u);
            else XB_SPIN(xb_ld(&bar[XB_TOPGEN]) == tg, bar);
            __builtin_amdgcn_fence(__ATOMIC_ACQUIRE, "agent");
            xb_add(&bar[XB_XGEN(b.x)], 1u);
            asm volatile("s_waitcnt vmcnt(0)" ::: "memory");
        } else {
            XB_SPIN(xb_ld(&bar[XB_XGEN(b.x)]) == gen, bar);
            __builtin_amdgcn_fence(__ATOMIC_ACQUIRE, "agent");
            asm volatile("s_waitcnt vmcnt(0)" ::: "memory");
        }
    }
    __syncthreads();
}


struct Params { const float* in[17]; float* out; unsigned char* ws; };
enum { I_X = 0, I_C, I_CTX, I_CCTX, I_WMOD, I_BMOD, I_WIN, I_WOUT, I_DF, I_DB, I_L1G, I_L1B, I_WG, I_WU, I_WD, I_L2G, I_L2B };

__device__ __forceinline__ float bf2f(unsigned v) { return __uint_as_float(v << 16); }
__device__ __forceinline__ unsigned pk2(float lo, float hi) { return pg8::cvt_pk_bf16(lo, hi); }
__device__ __forceinline__ float silu_f(float x) { return x * __builtin_amdgcn_rcpf(1.f + __expf(-x)); }
__device__ __forceinline__ float wave_sum(float v) {
#pragma unroll
    for (int o = 1; o < 64; o <<= 1) v += __shfl_xor(v, o);
    return v;
}
__device__ __forceinline__ float logsig(float x) { return fminf(x, 0.f) - log1pf(expf(-fabsf(x))); }
__device__ __forceinline__ bf16x8 lds_frag(const LAS bf16_t* p) { return *(const LAS bf16x8*)p; }
#define MFMA16(X, Y, ACC) __builtin_amdgcn_mfma_f32_16x16x32_bf16((X), (Y), (ACC), 0, 0, 0)

__device__ __forceinline__ void conv_tile(const float* W, int ldw, int ks0, int c0, int permtype, float scale, bf16_t* dst, int ldd, int j0, int kk0, LAS float* S, int tid) {
#pragma unroll
    for (int i = 0; i < 8; ++i) { const int idx = tid + 512 * i, r = idx >> 6, c = idx & 63; S[r * 65 + c] = W[(size_t)(ks0 + r) * ldw + c0 + c]; }
    __syncthreads();
    const int s = tid >> 3, ch = tid & 7; const int cs = (s & 32) + (permtype ? pg8::perm32(s & 31) : (s & 31));
    float v[8];
#pragma unroll
    for (int i = 0; i < 8; ++i) v[i] = S[(8 * ch + i) * 65 + cs] * scale;
    u32x4 o; o.x = pk2(v[0], v[1]); o.y = pk2(v[2], v[3]); o.z = pk2(v[4], v[5]); o.w = pk2(v[6], v[7]);
    *(u32x4*)(dst + (size_t)(j0 + s) * ldd + kk0 + 8 * ch) = o;
    __syncthreads();
}
__device__ __forceinline__ void fold_tile(const float* Win, int g, int kc, bf16_t* BtIn, LAS float* S, int tid) {
    LAS float* ct = S + 64 * 65; LAS float* st = ct + 64;
#pragma unroll
    for (int i = 0; i < 8; ++i) { const int idx = tid + 512 * i, r = idx >> 6, c = idx & 63; S[r * 65 + c] = Win[(size_t)(64 * kc + r) * 2560 + 64 * g + c]; }
    if (tid < 64) { float sv, cv; sincospif((float)tid * (1.f / 32.f), &sv, &cv); ct[tid] = cv; st[tid] = sv; }
    __syncthreads();
    const int s = tid >> 3, ch = tid & 7; const int cp = (s & 32) + pg8::perm32(s & 31);
    float ac[8], as[8];
#pragma unroll
    for (int i = 0; i < 8; ++i) { ac[i] = 0.f; as[i] = 0.f; }
    for (int c = 0; c < 64; ++c) { const int m = (c * cp) & 63; const float cv = ct[m], sv = st[m];
#pragma unroll
        for (int i = 0; i < 8; ++i) { const float a = S[(8 * ch + i) * 65 + c]; ac[i] += a * cv; as[i] += a * sv; } }
    u32x4 o; o.x = pk2(ac[0] * .125f, ac[1] * .125f); o.y = pk2(ac[2] * .125f, ac[3] * .125f); o.z = pk2(ac[4] * .125f, ac[5] * .125f); o.w = pk2(ac[6] * .125f, ac[7] * .125f);
    *(u32x4*)(BtIn + (size_t)(64 * g + s) * DM + 64 * kc + 8 * ch) = o;
    o.x = pk2(as[0] * .125f, as[1] * .125f); o.y = pk2(as[2] * .125f, as[3] * .125f); o.z = pk2(as[4] * .125f, as[5] * .125f); o.w = pk2(as[6] * .125f, as[7] * .125f);
    *(u32x4*)(BtIn + (size_t)(256 + 64 * g + s) * DM + 64 * kc + 8 * ch) = o;
    __syncthreads();
}
__device__ __forceinline__ void phase0a(const Params& p, LAS unsigned char* lds, int blk, int G, int tid) {
    unsigned char* ws = p.ws;
    LAS float* S = (LAS float*)lds;
    bf16_t* BtIn = (bf16_t*)(ws + OFF_BTIN); bf16_t* BtOut = (bf16_t*)(ws + OFF_BTOUT); bf16_t* BtGU = (bf16_t*)(ws + OFF_BTGU); bf16_t* BtD = (bf16_t*)(ws + OFF_BTD);
    if (blk < 192) {
        LAS float* sl = S; LAS float* red = S + 17 * 1024;
        for (int i = tid; i < 17 * 1024; i += 512) { const int r = i >> 10, k = i & 1023; const float v = r < 16 ? p.in[I_C][r * 1024 + k] : p.in[I_CCTX][k]; sl[i] = v / (1.f + expf(-v)); }
        __syncthreads();
        for (int t = blk; t < 192; t += G) {
            const int c0 = 32 * t, c4 = tid & 7, ks = tid >> 3;
            f32x4 acc[17];
#pragma unroll
            for (int r = 0; r < 17; ++r) acc[r] = (f32x4){0.f, 0.f, 0.f, 0.f};
            for (int kk = 0; kk < 16; ++kk) { const int k = 16 * ks + kk; const f32x4 w = *(const f32x4*)(p.in[I_WMOD] + (size_t)k * NMOD + c0 + 4 * c4);
#pragma unroll
                for (int r = 0; r < 17; ++r) acc[r] += sl[r * 1024 + k] * w; }
#pragma unroll
            for (int r = 0; r < 17; ++r)
#pragma unroll
                for (int j = 0; j < 4; ++j) { float v = acc[r][j]; v += __shfl_xor(v, 8); v += __shfl_xor(v, 16); v += __shfl_xor(v, 32); acc[r][j] = v; }
            const int lane = tid & 63, w = tid >> 6;
            if (lane < 8) {
#pragma unroll
                for (int r = 0; r < 17; ++r)
#pragma unroll
                    for (int j = 0; j < 4; ++j) red[(w * 17 + r) * 32 + 4 * c4 + j] = acc[r][j]; }
            __syncthreads();
            for (int i = tid; i < 17 * 32; i += 512) { const int r = i >> 5, cc = i & 31; float v = p.in[I_BMOD][c0 + cc];
#pragma unroll
                for (int ww = 0; ww < 8; ++ww) v += red[(ww * 17 + r) * 32 + cc];
                ((float*)(ws + OFF_MOD))[r * NMOD + c0 + cc] = v; }
            __syncthreads();
        }
    }
    if (blk == G - 1) {
        for (int i = tid; i < 1024; i += 512) { const int pos = i >> 4, fi = i & 15; const float f = (float)pow(10000.0, -(double)fi / 16.0); const float ang = (float)pos * f;
            double sv, cv; sincospi((double)ang * 0.31830988618379067154, &sv, &cv); ((float*)(ws + OFF_ROPE))[2 * i] = (float)cv; ((float*)(ws + OFF_ROPE))[2 * i + 1] = (float)sv; }
    }
    __syncthreads();
    for (int it = blk; it < 3072; it += G) {
        int r = it;
        if (r < 64) { fold_tile(p.in[I_WIN], r >> 4, r & 15, BtIn, S, tid); continue; } r -= 64;
        if (r < 576) { const int jt = r >> 4, kt = r & 15, jj0 = 64 * jt; conv_tile(p.in[I_WIN], 2560, 64 * kt, 256 + jj0, jj0 < 768 ? 0 : 1, (jj0 >= 384 && jj0 < 768) ? 0.125f : 1.f, BtIn, DM, 512 + jj0, 64 * kt, S, tid); continue; } r -= 576;
        if (r < 320) { const int kt = r >> 4, jt = r & 15, kk0 = 64 * kt; conv_tile(p.in[I_WOUT], 1024, kk0 < 256 ? kk0 : kk0 - 256, 64 * jt, 0, 1.f, BtOut, MIXW, 64 * jt, kk0, S, tid); continue; } r -= 320;
        if (r < 1408) { const int jt = r >> 4, kt = r & 15, pn = jt >> 2, q = jt & 3; conv_tile(q < 2 ? p.in[I_WG] : p.in[I_WU], DFF, 64 * kt, 128 * pn + 64 * (q & 1), 1, 1.f, BtGU, DM, 64 * jt, 64 * kt, S, tid); continue; } r -= 1408;
        { const int kt = r >> 4, jt = r & 15; conv_tile(p.in[I_WD], 1024, 64 * kt, 64 * jt, 0, 1.f, BtD, DFF, 64 * jt, 64 * kt, S, tid); }
    }
    for (int i = tid; i < 2048; i += 512) S[i] = cospif((float)i * (1.f / 1024.f)) * 0.02209708691207961f;
    __syncthreads();
    bf16_t* dft = (bf16_t*)(ws + OFF_DFT);
    for (int t = blk; t < 2048; t += G) {
        const int row = 2 * t + (tid >> 8), n0 = 8 * (tid & 255); const int np = row & 2047, off = row >= 2048 ? 512 : 0;
        float v[8];
#pragma unroll
        for (int i = 0; i < 8; ++i) v[i] = S[(np * (n0 + i) + off) & 2047];
        u32x4 o; o.x = pk2(v[0], v[1]); o.y = pk2(v[2], v[3]); o.z = pk2(v[4], v[5]); o.w = pk2(v[6], v[7]);
        *(u32x4*)(dft + (size_t)row * 2048 + n0) = o;
    }
}

__device__ __forceinline__ void load16(const float* row, int lane, float (&v)[16]) {
    const f32x4 a = *(const f32x4*)(row + 8 * lane), b = *(const f32x4*)(row + 8 * lane + 4), c = *(const f32x4*)(row + 512 + 8 * lane), d = *(const f32x4*)(row + 512 + 8 * lane + 4);
#pragma unroll
    for (int j = 0; j < 4; ++j) { v[j] = a[j]; v[4 + j] = b[j]; v[8 + j] = c[j]; v[12 + j] = d[j]; }
}
__device__ __forceinline__ void store16(float* row, int lane, const float (&v)[16]) {
    *(f32x4*)(row + 8 * lane) = (f32x4){v[0], v[1], v[2], v[3]}; *(f32x4*)(row + 8 * lane + 4) = (f32x4){v[4], v[5], v[6], v[7]};
    *(f32x4*)(row + 512 + 8 * lane) = (f32x4){v[8], v[9], v[10], v[11]}; *(f32x4*)(row + 512 + 8 * lane + 4) = (f32x4){v[12], v[13], v[14], v[15]};
}
__device__ __forceinline__ void store16_bf(bf16_t* row, int lane, const float (&v)[16]) {
    u32x4 o; o.x = pk2(v[0], v[1]); o.y = pk2(v[2], v[3]); o.z = pk2(v[4], v[5]); o.w = pk2(v[6], v[7]); *(u32x4*)(row + 8 * lane) = o;
    o.x = pk2(v[8], v[9]); o.y = pk2(v[10], v[11]); o.z = pk2(v[12], v[13]); o.w = pk2(v[14], v[15]); *(u32x4*)(row + 512 + 8 * lane) = o;
}
__device__ __forceinline__ void ln_norm(float (&v)[16]) {
    float s = 0.f;
#pragma unroll
    for (int i = 0; i < 16; ++i) s += v[i];
    const float mean = wave_sum(s) * (1.f / 1024.f); float s2 = 0.f;
#pragma unroll
    for (int i = 0; i < 16; ++i) { v[i] -= mean; s2 += v[i] * v[i]; }
    const float rstd = 1.f / sqrtf(wave_sum(s2) * (1.f / 1024.f) + LN_EPS);
#pragma unroll
    for (int i = 0; i < 16; ++i) v[i] *= rstd;
}
__device__ __forceinline__ void modulate16(float (&v)[16], const float* sh, const float* sc, int lane) {
    float a[16], b[16]; load16(sh, lane, a); load16(sc, lane, b);
#pragma unroll
    for (int i = 0; i < 16; ++i) v[i] = v[i] * (1.f + b[i]) + a[i];
}
__device__ __forceinline__ void affine16(float (&v)[16], const float* g, const float* be, int lane) {
    float a[16], b[16]; load16(g, lane, a); load16(be, lane, b);
#pragma unroll
    for (int i = 0; i < 16; ++i) v[i] = v[i] * a[i] + b[i];
}
__device__ __forceinline__ void phase0b(const Params& p, int blk, int G, int tid) {
    const int lane = tid & 63, gw = blk * 8 + (tid >> 6); const float* mod = (const float*)(p.ws + OFF_MOD); bf16_t* U = (bf16_t*)(p.ws + OFF_U);
    for (int row = gw; row < T_ALL; row += G * 8) {
        const float* src = row < T_LAT ? p.in[I_X] + (size_t)row * DM : p.in[I_CTX] + (size_t)(row - T_LAT) * DM; const int mr = row < T_LAT ? (row >> 11) : 16;
        float v[16]; load16(src, lane, v); ln_norm(v); modulate16(v, mod + mr * NMOD, mod + mr * NMOD + 1024, lane); store16_bf(U + (size_t)row * DM, lane, v);
    }
}
__device__ __forceinline__ void phase6(const Params& p, int blk, int G, int tid) {
    const int lane = tid & 63, gw = blk * 8 + (tid >> 6); const float* mod = (const float*)(p.ws + OFF_MOD); bf16_t* U2 = (bf16_t*)(p.ws + OFF_U); const float* Y1 = (const float*)(p.ws + OFF_P);
    for (int row = gw; row < T_LAT; row += G * 8) {
        float v[16]; load16(Y1 + (size_t)row * DM, lane, v); ln_norm(v); affine16(v, p.in[I_L1G], p.in[I_L1B], lane); store16(p.out + (size_t)row * DM, lane, v);
        ln_norm(v); const int mr = row >> 11; modulate16(v, mod + mr * NMOD + 3072, mod + mr * NMOD + 4096, lane); store16_bf(U2 + (size_t)row * DM, lane, v);
    }
}
__device__ __forceinline__ void phase9(const Params& p, int blk, int G, int tid) {
    const int lane = tid & 63, gw = blk * 8 + (tid >> 6);
    for (int row = gw; row < T_LAT; row += G * 8) {
        float v[16]; load16(p.out + (size_t)row * DM, lane, v); ln_norm(v); affine16(v, p.in[I_L2G], p.in[I_L2B], lane); store16(p.out + (size_t)row * DM, lane, v);
    }
}
struct SchedIn {
    pg8::StaticOrder so; int G, c;
    __device__ bool next(int i, pg8::Unit& u) const {
        const long L = (long)i * G + c;
        if (L < 1408) return so.next(i, u);
        if (L < 1488) { const int r = (int)L - 1408; u.pm = 128 + r / 5; u.pn = 3 + r % 5; return true; }
        return false;
    }
    __device__ __forceinline__ void a_ready(const pg8::Unit&) const {}
    __device__ __forceinline__ void done(const pg8::Unit&) const {}
};
struct SchedF {
    int G, c;
    __device__ bool next(int i, pg8::Unit& u) const {
        const long L = (long)i * G + c; if (L >= 256) return false;
        const int x = (int)L & 7, ii = (int)L >> 3, b = 2 * x + (ii >> 4), part = (ii >> 3) & 1, pmm = ii & 7;
        u.pm = part * 8 + pmm; u.pn = 2 * b + part; return true;
    }
    __device__ __forceinline__ void a_ready(const pg8::Unit&) const {}
    __device__ __forceinline__ void done(const pg8::Unit&) const {}
};
struct EpiIn {
    static constexpr bool PERM = false, AFTER_DRAIN = false;
    bf16_t* P; const float* rope;
    __device__ __forceinline__ void operator()(const f32x4 (&acc)[2][2][4][2], const pg8::Unit& u, int wr, int wc, int fr, int fq) const {
        const int row0 = u.pm * 256 + wr * 64 + fr; const bool lat = u.pm < 128;
#pragma unroll
        for (int bj = 0; bj < 2; ++bj) {
            const int cb = u.pn * 256 + bj * 128;
            if (cb < 512 || cb >= 1280) {
#pragma unroll
                for (int ai = 0; ai < 2; ++ai)
#pragma unroll
                    for (int m = 0; m < 4; ++m) { const int row = row0 + ai * 128 + m * 16; const f32x4 v0 = acc[ai][bj][m][0], v1 = acc[ai][bj][m][1];
                        u32x4 o; o.x = pk2(v0[0], v0[1]); o.y = pk2(v0[2], v0[3]); o.z = pk2(v1[0], v1[1]); o.w = pk2(v1[2], v1[3]);
                        *(u32x4*)(P + (size_t)row * NP + cb + 32 * wc + 8 * fq) = o; }
            } else {
#pragma unroll
                for (int ai = 0; ai < 2; ++ai)
#pragma unroll
                    for (int m = 0; m < 4; ++m) { const int row = row0 + ai * 128 + m * 16; f32x4 x1 = acc[ai][bj][m][0], x2 = acc[ai][bj][m][1];
                        if (lat) { const int t = row & 2047, pos = (wc & 1) ? (t & 63) : (t >> 6); const f32x4* rp = (const f32x4*)(rope + (pos * 16 + 4 * fq) * 2); const f32x4 r0 = rp[0], r1 = rp[1];
                            const f32x4 cs = (f32x4){r0[0], r0[2], r1[0], r1[2]}, sn = (f32x4){r0[1], r0[3], r1[1], r1[3]};
                            const f32x4 o1 = x1 * cs - x2 * sn, o2 = x1 * sn + x2 * cs; x1 = o1; x2 = o2; }
                        u32x2 a, b; a.x = pk2(x1[0], x1[1]); a.y = pk2(x1[2], x1[3]); b.x = pk2(x2[0], x2[1]); b.y = pk2(x2[2], x2[3]);
                        bf16_t* d = P + (size_t)row * NP + cb + 32 * wc + 4 * fq; *(u32x2*)d = a; *(u32x2*)(d + 16) = b; }
            }
        }
    }
};
struct EpiRes {
    static constexpr bool PERM = false, AFTER_DRAIN = false;
    float* Y; const float* X; const float* gate;
    __device__ __forceinline__ void operator()(const f32x4 (&acc)[2][2][4][2], const pg8::Unit& u, int wr, int wc, int fr, int fq) const {
        const int row0 = u.pm * 256 + wr * 64 + fr, col0 = u.pn * 256 + wc * 32 + 4 * fq; const float* gp = gate + (size_t)(u.pm >> 3) * NMOD + col0;
        f32x4 gv[2][2];
#pragma unroll
        for (int bj = 0; bj < 2; ++bj)
#pragma unroll
            for (int n = 0; n < 2; ++n) gv[bj][n] = *(const f32x4*)(gp + bj * 128 + n * 16);
#pragma unroll
        for (int ai = 0; ai < 2; ++ai)
#pragma unroll
            for (int m = 0; m < 4; ++m) { const size_t ro = (size_t)(row0 + ai * 128 + m * 16) * DM + col0;
#pragma unroll
                for (int bj = 0; bj < 2; ++bj)
#pragma unroll
                    for (int n = 0; n < 2; ++n) { const f32x4 xv = *(const f32x4*)(X + ro + bj * 128 + n * 16); *(f32x4*)(Y + ro + bj * 128 + n * 16) = ALPHA * xv + gv[bj][n] * acc[ai][bj][m][n]; } }
    }
};
struct EpiUp {
    static constexpr bool PERM = false, AFTER_DRAIN = false;
    bf16_t* H;
    __device__ __forceinline__ void operator()(const f32x4 (&acc)[2][2][4][2], const pg8::Unit& u, int wr, int wc, int fr, int fq) const {
        const int row0 = u.pm * 256 + wr * 64 + fr, col0 = u.pn * 128 + wc * 32 + 8 * fq;
#pragma unroll
        for (int ai = 0; ai < 2; ++ai)
#pragma unroll
            for (int m = 0; m < 4; ++m) { float h[8];
#pragma unroll
                for (int n = 0; n < 2; ++n)
#pragma unroll
                    for (int j = 0; j < 4; ++j) h[4 * n + j] = silu_f(acc[ai][0][m][n][j]) * acc[ai][1][m][n][j];
                u32x4 o; o.x = pk2(h[0], h[1]); o.y = pk2(h[2], h[3]); o.z = pk2(h[4], h[5]); o.w = pk2(h[6], h[7]);
                *(u32x4*)(H + (size_t)(row0 + ai * 128 + m * 16) * DFF + col0) = o; }
    }
};
struct EpiF {
    static constexpr bool PERM = false, AFTER_DRAIN = false;
    bf16_t* MIX;
    __device__ __forceinline__ void operator()(const f32x4 (&acc)[2][2][4][2], const pg8::Unit& u, int wr, int wc, int fr, int fq) const {
        const int part = u.pm >> 3, pmm = u.pm & 7, b = u.pn >> 1; const int row0 = b * 2048 + pmm * 256 + wr * 64 + fr, col0 = part * 256 + wc * 32 + 4 * fq;
#pragma unroll
        for (int ai = 0; ai < 2; ++ai)
#pragma unroll
            for (int m = 0; m < 4; ++m) { bf16_t* rp = MIX + (size_t)(row0 + ai * 128 + m * 16) * MIXW + col0;
#pragma unroll
                for (int bj = 0; bj < 2; ++bj)
#pragma unroll
                    for (int n = 0; n < 2; ++n) { const f32x4 v = acc[ai][bj][m][n]; u32x2 o; o.x = pk2(v[0], v[1]); o.y = pk2(v[2], v[3]); *(u32x2*)(rp + bj * 128 + n * 16) = o; } }
    }
};

__device__ __forceinline__ void ft_item(const bf16_t* P, bf16_t* FT, int item, LAS bf16_t* T, int tid) {
    const int ti = item >> 3, ci = item & 7, r0 = 64 * ti, b = r0 >> 11, n0 = r0 & 2047, ch0 = 64 * ci;
    { const int tok = tid >> 3, oct = tid & 7; const u32x4 v = *(const u32x4*)(P + (size_t)(r0 + tok) * NP + ch0 + 8 * oct);
#pragma unroll
      for (int j = 0; j < 4; ++j) { T[(8 * oct + 2 * j) * 66 + tok] = (bf16_t)(v[j] & 0xffffu); T[(8 * oct + 2 * j + 1) * 66 + tok] = (bf16_t)(v[j] >> 16); } }
    __syncthreads();
    { const int ch = tid >> 3, to = tid & 7; const LAS unsigned* s = (const LAS unsigned*)(T + ch * 66 + 8 * to); u32x4 o; o.x = s[0]; o.y = s[1]; o.z = s[2]; o.w = s[3];
      *(u32x4*)(FT + (size_t)(b * 512 + ch0 + ch) * 2048 + n0 + 8 * to) = o; }
    __syncthreads();
}
__device__ __forceinline__ void load_vt(const bf16_t* Pv, LAS bf16_t* Vt, int tid) {
#pragma unroll
    for (int i = 0; i < 4; ++i) { const int idx = tid + 512 * i, l = idx >> 4, oct = idx & 15; const u32x4 v = *(const u32x4*)(Pv + (size_t)l * NP + 8 * oct);
#pragma unroll
        for (int j = 0; j < 4; ++j) { Vt[(8 * oct + 2 * j) * 136 + l] = (bf16_t)(v[j] & 0xffffu); Vt[(8 * oct + 2 * j + 1) * 136 + l] = (bf16_t)(v[j] >> 16); } }
}
__device__ __forceinline__ void state_unit(const Params& p, int u, LAS bf16_t* sm, int tid) {
    const bf16_t* P = (const bf16_t*)(p.ws + OFF_P); float* ST = (float*)(p.ws + OFF_ST);
    int h, R0;
    if (u < 1536) { const int b = u / 96, c = u & 15; h = (u >> 4) % 6; R0 = b * 2048 + 128 * c; }
    else { const int uu = u - 1536, b = uu / 12, c = uu & 1; h = (uu >> 1) % 6; R0 = T_LAT + b * 256 + 128 * c; }
    const float lgf = logsig(p.in[I_DF][h]), lgb = logsig(p.in[I_DB][h]);
    LAS bf16_t* Vt = sm; LAS bf16_t* Kf = Vt + 128 * 136; LAS bf16_t* Kb = Kf + 64 * 136;
    load_vt(P + (size_t)R0 * NP + 1280 + 128 * h, Vt, tid);
#pragma unroll
    for (int i = 0; i < 2; ++i) { const int idx = tid + 512 * i, l = idx >> 3, oct = idx & 7; const u32x4 v = *(const u32x4*)(P + (size_t)(R0 + l) * NP + 896 + 64 * h + 8 * oct);
        const float zf = __expf(lgf * (float)(127 - l)), zb = __expf(lgb * (float)l);
#pragma unroll
        for (int j = 0; j < 4; ++j) { const float k0 = bf2f(v[j] & 0xffffu), k1 = bf2f(v[j] >> 16); const unsigned f2 = pk2(k0 * zf, k1 * zf), b2 = pk2(k0 * zb, k1 * zb);
            Kf[(8 * oct + 2 * j) * 136 + l] = (bf16_t)(f2 & 0xffffu); Kf[(8 * oct + 2 * j + 1) * 136 + l] = (bf16_t)(f2 >> 16);
            Kb[(8 * oct + 2 * j) * 136 + l] = (bf16_t)(b2 & 0xffffu); Kb[(8 * oct + 2 * j + 1) * 136 + l] = (bf16_t)(b2 >> 16); } }
    __syncthreads();
    const int w = tid >> 6, lane = tid & 63, fr = lane & 15, q = lane >> 4;
#pragma unroll
    for (int dir = 0; dir < 2; ++dir) { const LAS bf16_t* Kz = dir ? Kb : Kf; f32x4 acc[4];
#pragma unroll
        for (int dt = 0; dt < 4; ++dt) acc[dt] = (f32x4){0.f, 0.f, 0.f, 0.f};
#pragma unroll
        for (int ks = 0; ks < 4; ++ks) { const bf16x8 y = lds_frag(Vt + (16 * w + fr) * 136 + 32 * ks + 8 * q);
#pragma unroll
            for (int dt = 0; dt < 4; ++dt) acc[dt] = MFMA16(lds_frag(Kz + (16 * dt + fr) * 136 + 32 * ks + 8 * q), y, acc[dt]); }
        float* o = ST + ((size_t)(u * 2 + dir) * 128 + 16 * w + fr) * 64 + 4 * q;
#pragma unroll
        for (int dt = 0; dt < 4; ++dt) *(f32x4*)(o + 16 * dt) = acc[dt]; }
    __syncthreads();
}
__device__ __forceinline__ void phase2(const Params& p, LAS unsigned char* lds, int blk, int G, int tid) {
    const bf16_t* P = (const bf16_t*)(p.ws + OFF_P); bf16_t* FT = (bf16_t*)(p.ws + OFF_U);
    for (int it = blk; it < 4096; it += G) ft_item(P, FT, it, (LAS bf16_t*)lds, tid);
    for (int u = blk; u < 1728; u += G) state_unit(p, u, (LAS bf16_t*)lds, tid);
}
__device__ __forceinline__ void phase3(const Params& p, int blk, int G, int tid) {
    const float* ST = (const float*)(p.ws + OFF_ST); bf16_t* SBF = (bf16_t*)(p.ws + OFF_SBF);
    for (int it = blk * NTHREADS + tid; it < 96 * 2 * 2048; it += G * NTHREADS) {
        const int e4 = it & 2047, dir = (it >> 11) & 1, bh = it >> 12, h = bh % 6;
        const float lg = logsig(dir ? p.in[I_DB][h] : p.in[I_DF][h]), g128 = expf(lg * 128.f);
        const f32x4 c0 = *(const f32x4*)(ST + ((size_t)(1536 + bh * 2) * 2 + dir) * 8192 + 4 * e4), c1 = *(const f32x4*)(ST + ((size_t)(1536 + bh * 2 + 1) * 2 + dir) * 8192 + 4 * e4);
        f32x4 s = dir ? (c0 + g128 * c1) : (g128 * c0 + c1);
        for (int i = 0; i < 16; ++i) { const int c = dir ? 15 - i : i; const size_t o = ((size_t)(bh * 16 + c) * 2 + dir) * 8192 + 4 * e4;
            u32x2 w; w.x = pk2(s[0], s[1]); w.y = pk2(s[2], s[3]); *(u32x2*)(SBF + o) = w;
            s = g128 * s + *(const f32x4*)(ST + o); }
    }
}
__device__ __forceinline__ void ret_unit(const Params& p, int u, LAS bf16_t* sm, int tid) {
    const bf16_t* P = (const bf16_t*)(p.ws + OFF_P); const bf16_t* SBF = (const bf16_t*)(p.ws + OFF_SBF); bf16_t* MIX = (bf16_t*)(p.ws + OFF_ST);
    const int b = u / 96, c = u & 15, h = (u >> 4) % 6, R0 = b * 2048 + 128 * c;
    const float lgf = logsig(p.in[I_DF][h]), lgb = logsig(p.in[I_DB][h]);
    LAS bf16_t* Qs = sm; LAS bf16_t* Ks = Qs + 128 * 72; LAS bf16_t* Ps = Ks + 128 * 72; LAS bf16_t* Vt = Ps + 128 * 136; LAS bf16_t* Sf = Vt + 128 * 136; LAS bf16_t* Sb = Sf + 128 * 72;
#pragma unroll
    for (int i = 0; i < 2; ++i) { const int idx = tid + 512 * i, l = idx >> 3, oct = idx & 7; const bf16_t* src = P + (size_t)(R0 + l) * NP + 64 * h + 8 * oct;
        *(LAS u32x4*)(Qs + l * 72 + 8 * oct) = *(const u32x4*)(src + 512); *(LAS u32x4*)(Ks + l * 72 + 8 * oct) = *(const u32x4*)(src + 896);
        *(LAS u32x4*)(Sf + l * 72 + 8 * oct) = *(const u32x4*)(SBF + (size_t)(u * 2) * 8192 + idx * 8); *(LAS u32x4*)(Sb + l * 72 + 8 * oct) = *(const u32x4*)(SBF + (size_t)(u * 2 + 1) * 8192 + idx * 8); }
    load_vt(P + (size_t)R0 * NP + 1280 + 128 * h, Vt, tid);
    __syncthreads();
    const int w = tid >> 6, lane = tid & 63, fr = lane & 15, q = lane >> 4, ci = 16 * w + fr;
    bf16x8 yq[2]; yq[0] = lds_frag(Qs + ci * 72 + 8 * q); yq[1] = lds_frag(Qs + ci * 72 + 32 + 8 * q);
#pragma unroll
    for (int lt = 0; lt < 8; ++lt) { f32x4 a = (f32x4){0.f, 0.f, 0.f, 0.f};
        a = MFMA16(lds_frag(Ks + (16 * lt + fr) * 72 + 8 * q), yq[0], a); a = MFMA16(lds_frag(Ks + (16 * lt + fr) * 72 + 32 + 8 * q), yq[1], a);
        float pv[4];
#pragma unroll
        for (int j = 0; j < 4; ++j) { const int d = ci - (16 * lt + 4 * q + j); pv[j] = a[j] * __expf(d >= 0 ? lgf * (float)d : -lgb * (float)d); }
        u32x2 o; o.x = pk2(pv[0], pv[1]); o.y = pk2(pv[2], pv[3]); *(LAS u32x2*)(Ps + ci * 136 + 16 * lt + 4 * q) = o; }
    __syncthreads();
    f32x4 ai[8], af[8], ab[8];
#pragma unroll
    for (int et = 0; et < 8; ++et) { ai[et] = (f32x4){0.f, 0.f, 0.f, 0.f}; af[et] = ai[et]; ab[et] = ai[et]; }
#pragma unroll
    for (int ks = 0; ks < 4; ++ks) { const bf16x8 y = lds_frag(Ps + ci * 136 + 32 * ks + 8 * q);
#pragma unroll
        for (int et = 0; et < 8; ++et) ai[et] = MFMA16(lds_frag(Vt + (16 * et + fr) * 136 + 32 * ks + 8 * q), y, ai[et]); }
#pragma unroll
    for (int ks = 0; ks < 2; ++ks) {
#pragma unroll
        for (int et = 0; et < 8; ++et) { af[et] = MFMA16(lds_frag(Sf + (16 * et + fr) * 72 + 32 * ks + 8 * q), yq[ks], af[et]); ab[et] = MFMA16(lds_frag(Sb + (16 * et + fr) * 72 + 32 * ks + 8 * q), yq[ks], ab[et]); } }
    const float xf = __expf(lgf * (float)(ci + 1)), xb = __expf(lgb * (float)(128 - ci)); float ss = 0.f;
#pragma unroll
    for (int et = 0; et < 8; ++et) { ai[et] = ai[et] + xf * af[et] + xb * ab[et]; ss += ai[et][0] * ai[et][0] + ai[et][1] * ai[et][1] + ai[et][2] * ai[et][2] + ai[et][3] * ai[et][3]; }
    ss += __shfl_xor(ss, 16); ss += __shfl_xor(ss, 32);
    const float rn = 1.f / sqrtf(ss * (1.f / 128.f) + LN_EPS);
    const bf16_t* gp = P + (size_t)(R0 + ci) * NP + 2048 + 128 * h + 4 * q; bf16_t* op = MIX + (size_t)(R0 + ci) * MIXW + 512 + 128 * h + 4 * q;
#pragma unroll
    for (int et = 0; et < 8; ++et) { const u32x2 gv = *(const u32x2*)(gp + 16 * et);
        const float g0 = bf2f(gv.x & 0xffffu), g1 = bf2f(gv.x >> 16), g2 = bf2f(gv.y & 0xffffu), g3 = bf2f(gv.y >> 16);
        u32x2 o; o.x = pk2(ai[et][0] * rn * silu_f(g0), ai[et][1] * rn * silu_f(g1)); o.y = pk2(ai[et][2] * rn * silu_f(g2), ai[et][3] * rn * silu_f(g3));
        *(u32x2*)(op + 16 * et) = o; }
    __syncthreads();
}

__global__ __launch_bounds__(512, 2) void fwd_megakernel(Params p) {
    extern __shared__ __attribute__((aligned(16))) unsigned char shm[];
    LAS unsigned char* lds = (LAS unsigned char*)shm;
    cg::grid_group grid = cg::this_grid();
    const int tid = threadIdx.x, blk = blockIdx.x, G = gridDim.x;
    unsigned char* ws = p.ws;
    volatile LAS unsigned* xst = (volatile LAS unsigned*)(lds + LDS_BYTES - 16);
    if (tid < 4) xst[tid] = 0u;
    if (blk == 0) for (int i = tid; i < XCD_BAR_WORDS; i += NTHREADS) ((unsigned*)ws)[i] = 0u;
    __syncthreads();
    phase0a(p, lds, blk, G, tid);
    grid.sync();
    const XcdBarrier xb = xcd_barrier_post((unsigned*)ws, xst);
    phase0b(p, blk, G, tid);
    xcd_barrier(xb);
    {
        pg8::Gemm g{(const bf16_t*)(ws + OFF_U), (const bf16_t*)(ws + OFF_BTIN), T_ALL, NP, DM};
        SchedIn S; S.so.init(T_LAT, NP, G, blk); S.G = G; S.c = blk;
        EpiIn E{(bf16_t*)(ws + OFF_P), (const float*)(ws + OFF_ROPE)};
        pg8::gemm_phase<EpiIn, SchedIn, true, true>(lds, g, S, E);
    }
    xcd_barrier(xb);
    phase2(p, lds, blk, G, tid);
    xcd_barrier(xb);
    phase3(p, blk, G, tid);
    xcd_barrier(xb);
    {
        pg8::Gemm g{(const bf16_t*)(ws + OFF_DFT), (const bf16_t*)(ws + OFF_U), 4096, 8192, 2048};
        SchedF S{G, blk}; EpiF E{(bf16_t*)(ws + OFF_ST)};
        pg8::gemm_phase<EpiF, SchedF, true, true>(lds, g, S, E);
        __syncthreads();
        for (int u = blk; u < 1536; u += G) ret_unit(p, u, (LAS bf16_t*)lds, tid);
    }
    xcd_barrier(xb);
    {
        pg8::Gemm g{(const bf16_t*)(ws + OFF_ST), (const bf16_t*)(ws + OFF_BTOUT), T_LAT, DM, MIXW};
        pg8::StaticOrder S; S.init(T_LAT, DM, G, blk);
        EpiRes E{(float*)(ws + OFF_P), p.in[I_X], (const float*)(ws + OFF_MOD) + 2048};
        pg8::gemm_phase<EpiRes, pg8::StaticOrder, true, true>(lds, g, S, E);
    }
    xcd_barrier(xb);
    phase6(p, blk, G, tid);
    xcd_barrier(xb);
    {
        pg8::Gemm g{(const bf16_t*)(ws + OFF_U), (const bf16_t*)(ws + OFF_BTGU), T_LAT, 2 * DFF, DM};
        pg8::StaticOrder S; S.init(T_LAT, 2 * DFF, G, blk);
        EpiUp E{(bf16_t*)(ws + OFF_P)};
        pg8::gemm_phase<EpiUp, pg8::StaticOrder, true, true>(lds, g, S, E);
    }
    xcd_barrier(xb);
    {
        pg8::Gemm g{(const bf16_t*)(ws + OFF_P), (const bf16_t*)(ws + OFF_BTD), T_LAT, DM, DFF};
        pg8::StaticOrder S; S.init(T_LAT, DM, G, blk);
        EpiRes E{p.out, p.out, (const float*)(ws + OFF_MOD) + 5120};
        pg8::gemm_phase<EpiRes, pg8::StaticOrder, true, true>(lds, g, S, E);
    }
    xcd_barrier(xb);
    phase9(p, blk, G, tid);
}

extern "C" void kernel_launch(void* const* d_in, const int* in_sizes, int n_in, void* d_out, int out_size, void* d_ws, size_t ws_size, hipStream_t stream) {
    static int grid = 0;
    if (grid == 0) {
        if (n_in != 17 || out_size != T_LAT * DM || ws_size < WS_END) { fprintf(stderr, "kernel_launch: unexpected shapes (n_in %d, out %d, ws %zu < %zu)\n", n_in, out_size, ws_size, (size_t)WS_END); grid = -1; return; }
        int dev = 0, cus = 0, per_cu = 0;
        hipGetDevice(&dev); hipDeviceGetAttribute(&cus, hipDeviceAttributeMultiprocessorCount, dev);
        if (hipFuncSetAttribute((const void*)fwd_megakernel, hipFuncAttributeMaxDynamicSharedMemorySize, LDS_BYTES) != hipSuccess) { fprintf(stderr, "kernel_launch: hipFuncSetAttribute failed\n"); grid = -1; return; }
        if (hipOccupancyMaxActiveBlocksPerMultiprocessor(&per_cu, (const void*)fwd_megakernel, NTHREADS, LDS_BYTES) != hipSuccess || per_cu < 1) { fprintf(stderr, "kernel_launch: occupancy query failed (%d)\n", per_cu); grid = -1; return; }
        grid = cus * per_cu;
    }
    if (grid < 0) return;
    Params p{};
    for (int i = 0; i < 17; ++i) p.in[i] = (const float*)d_in[i];
    p.out = (float*)d_out; p.ws = (unsigned char*)d_ws;
    void* args[] = {&p};
    hipError_t e = hipLaunchCooperativeKernel((const void*)fwd_megakernel, dim3(grid), dim3(NTHREADS), args, LDS_BYTES, stream);
    if (e != hipSuccess) fprintf(stderr, "kernel_launch: cooperative launch failed: %s (grid %d)\n", hipGetErrorString(e), grid);
}
```
